# Optimizing an MI355X kernel written in HIP

```python
import math
import jax
import jax.numpy as jnp
from jax import lax
import numpy as np

D_MODEL = 1024
BATCH = 8
SEQ = 2048
DEPTH = 4
DEC_BATCH = 32
DEC_SEQ = 1
PAST_LEN = 8192
PAGE_SIZE = 128

HEAD_DIM = 64
HEADS_PER_GROUP = 4
ATTN_GROUPS = ((128, 1), (512, 4), (2048, 16))
N_ATTN_HEADS = HEADS_PER_GROUP * len(ATTN_GROUPS)
ATTN_QKV_WIDTH = N_ATTN_HEADS * HEAD_DIM
ATTN_OUT_WIDTH = HEADS_PER_GROUP * HEAD_DIM
ROT_DIM = HEAD_DIM // 4
ROPE_THETA = 500000.0
BAND_BLOCK = 128
CHUNK = 128
GMLP_GROUPS = 4
GMLP_GROUP_DIM = 192
GMLP_WIDTH = GMLP_GROUPS * GMLP_GROUP_DIM
EPS = 1e-6
IN_WIDTHS = (ATTN_QKV_WIDTH, ATTN_QKV_WIDTH, ATTN_QKV_WIDTH, ATTN_OUT_WIDTH, GMLP_WIDTH, GMLP_WIDTH, GMLP_WIDTH, 2 * D_MODEL)
N_IN = sum(IN_WIDTHS)
SPLITS = tuple(sum(IN_WIDTHS[:i + 1]) for i in range(len(IN_WIDTHS) - 1))

kernel_name = 'hybrid_dilated_attn_gmlp_decode_step'


def rms_norm(x, g):
    xf = x.astype(jnp.float32)
    y = xf * lax.rsqrt(jnp.mean(xf * xf, axis=-1, keepdims=True) + EPS)
    return (y * g.astype(jnp.float32)).astype(x.dtype)


def layer_norm(x, g, b):
    xf = x.astype(jnp.float32)
    xc = xf - jnp.mean(xf, axis=-1, keepdims=True)
    y = xc * lax.rsqrt(jnp.mean(xc * xc, axis=-1, keepdims=True) + EPS)
    return (y * g.astype(jnp.float32) + b.astype(jnp.float32)).astype(x.dtype)


def rope_partial(x, pos):
    half = ROT_DIM // 2
    inv_freq = jnp.power(ROPE_THETA, -jnp.arange(half, dtype=jnp.float32) / half)
    ang = pos.astype(jnp.float32)[:, None] * inv_freq[None, :]
    cos = jnp.cos(ang)[:, None, :]
    sin = jnp.sin(ang)[:, None, :]
    xr = x[..., :ROT_DIM].astype(jnp.float32)
    x1, x2 = xr[..., :half], xr[..., half:]
    rot = jnp.concatenate([x1 * cos - x2 * sin, x2 * cos + x1 * sin], axis=-1)
    return jnp.concatenate([rot.astype(x.dtype), x[..., ROT_DIM:]], axis=-1)


def dilated_band_prompt(q, k, v, window, dilation):
    B, S, H, hd = q.shape
    n = S // dilation
    span = window // dilation
    qlen = math.gcd(n, BAND_BLOCK)
    nblk = n // qlen

    def to_sub(t):
        return t.reshape(B, n, dilation, H, hd).transpose(0, 2, 1, 3, 4)

    qs = to_sub(q).reshape(B, dilation, nblk, qlen, H, hd)
    pad = ((0, 0), (0, 0), (span, 0), (0, 0), (0, 0))
    kp = jnp.pad(to_sub(k), pad)
    vp = jnp.pad(to_sub(v), pad)
    kidx = jnp.arange(nblk)[:, None] * qlen + jnp.arange(qlen + span)[None, :]
    kb = kp[:, :, kidx]
    vb = vp[:, :, kidx]
    blk = jnp.arange(nblk)[:, None, None]
    qi = jnp.arange(qlen)[None, :, None]
    kj = jnp.arange(qlen + span)[None, None, :]
    dist = qi - kj + span
    valid = (dist >= 0) & (dist <= span) & (blk * qlen + kj >= span)
    scores = jnp.einsum('brnqhd,brnkhd->brnhqk', qs, kb, preferred_element_type=jnp.float32) * (hd ** -0.5)
    scores = jnp.where(valid[:, None], scores, -jnp.inf)
    lse = jax.nn.logsumexp(scores, axis=-1)
    p = jnp.exp(scores - lse[..., None]).astype(v.dtype)
    o = jnp.einsum('brnhqk,brnkhd->brnqhd', p, vb)
    o = o.reshape(B, dilation, n, H, hd).transpose(0, 2, 1, 3, 4).reshape(B, S, H, hd)
    lse = jnp.swapaxes(lse, -1, -2).reshape(B, dilation, n, H).transpose(0, 2, 1, 3).reshape(B, S, H)
    return o, lse


def dilated_band_sample(q, k, v, kv_cache, window, dilation):
    L = kv_cache.shape[1]
    T = q.shape[1]
    hd = q.shape[-1]
    span = window // dilation
    kc = jnp.concatenate([kv_cache[:, :, 0], k], axis=1)
    vc = jnp.concatenate([kv_cache[:, :, 1], v], axis=1)
    rows = L + jnp.arange(T)[:, None] - dilation * jnp.arange(span + 1)[None, :]
    valid = rows >= 0
    rows = jnp.maximum(rows, 0)
    kg = kc[:, rows]
    vg = vc[:, rows]
    scores = jnp.einsum('bthd,btjhd->bhtj', q, kg, preferred_element_type=jnp.float32) * (hd ** -0.5)
    scores = jnp.where(valid[None, None], scores, -jnp.inf)
    lse = jax.nn.logsumexp(scores, axis=-1)
    p = jnp.exp(scores - lse[..., None]).astype(v.dtype)
    o = jnp.einsum('bhtj,btjhd->bthd', p, vg)
    return o, jnp.swapaxes(lse, 1, 2)


def layer_step(x, pos, kv_caches, g_pre, w_in, b_merge, v_norm_g, v_norm_b, w_s, b_s, w_pa, w_pb, w_out, g_post):
    B, T, _ = x.shape
    z = rms_norm(x, g_pre) @ w_in
    q, k, v, gate_a, u, vb, gate_b, merge_logits = jnp.split(z, SPLITS, axis=-1)
    q = rope_partial(q.reshape(B, T, N_ATTN_HEADS, HEAD_DIM), pos)
    k = rope_partial(k.reshape(B, T, N_ATTN_HEADS, HEAD_DIM), pos)
    v = v.reshape(B, T, N_ATTN_HEADS, HEAD_DIM)
    outs, lses, kv_rows = [], [], []
    for g, (window, dilation) in enumerate(ATTN_GROUPS):
        hs = slice(g * HEADS_PER_GROUP, (g + 1) * HEADS_PER_GROUP)
        qg, kg, vg = q[:, :, hs], k[:, :, hs], v[:, :, hs]
        if kv_caches is None:
            o, lse = dilated_band_prompt(qg, kg, vg, window, dilation)
            keep = min(window, T)
            kv_rows.append(jnp.stack([kg[:, T - keep:], vg[:, T - keep:]], axis=2))
        else:
            o, lse = dilated_band_sample(qg, kg, vg, kv_caches[g], window, dilation)
            kv_rows.append(jnp.stack([kg, vg], axis=2))
        outs.append(o)
        lses.append(lse)
    alpha = jax.nn.softmax(jnp.stack(lses, axis=0), axis=0)[..., None]
    attn = jnp.sum(alpha * jnp.stack(outs, axis=0).astype(jnp.float32), axis=0)
    attn = attn.reshape(B, T, ATTN_OUT_WIDTH).astype(x.dtype)
    u = jax.nn.gelu(u)
    vn = layer_norm(jax.nn.gelu(vb), v_norm_g, v_norm_b)
    cl = CHUNK if kv_caches is None else T
    ws = jnp.where(jnp.tril(jnp.ones((CHUNK, CHUNK), dtype=bool)), w_s, 0)[:, :cl, :cl]
    vc = vn.reshape(B, T // cl, cl, GMLP_GROUPS, GMLP_GROUP_DIM)
    mix = jnp.einsum('gij,bnjgc->bnigc', ws, vc) + jnp.swapaxes(b_s[:, :cl], 0, 1)[:, :, None]
    sgu = u * mix.reshape(B, T, GMLP_WIDTH)
    branch_a = (attn * jax.nn.silu(gate_a)) @ w_pa
    branch_b = (sgu * jax.nn.silu(gate_b)) @ w_pb
    gates = jax.nn.sigmoid(merge_logits + b_merge)
    merged = gates[..., :D_MODEL] * branch_a + gates[..., D_MODEL:] * branch_b
    x = x + rms_norm(merged @ w_out, g_post)
    return x, kv_rows, vn


def setup_inputs(seed: int = 0) -> dict:
    key = jax.random.key(seed)
    ks = jax.random.split(key, 16)

    def nrm(k, shape, scale=1.0):
        return scale * jax.random.normal(k, shape, jnp.float32)

    def cache_shape(window):
        return (DEPTH, DEC_BATCH, min(window, PAST_LEN), 2, HEADS_PER_GROUP, HEAD_DIM)

    return {
        'x_prompt': nrm(ks[0], (BATCH, SEQ, D_MODEL)),
        'x_sample': nrm(ks[1], (DEC_BATCH, DEC_SEQ, D_MODEL)),
        'cache_kv_w128': nrm(ks[2], cache_shape(ATTN_GROUPS[0][0])),
        'cache_kv_w512': nrm(ks[3], cache_shape(ATTN_GROUPS[1][0])),
        'cache_kv_w2048': nrm(ks[4], cache_shape(ATTN_GROUPS[2][0])),
        'norm_pre': 1.0 + nrm(ks[5], (DEPTH, D_MODEL), 0.02),
        'w_in': nrm(ks[6], (DEPTH, D_MODEL, N_IN), D_MODEL ** -0.5),
        'b_merge': nrm(ks[7], (DEPTH, 2 * D_MODEL), 0.02),
        'v_norm_g': 1.0 + nrm(ks[8], (DEPTH, GMLP_WIDTH), 0.02),
        'v_norm_b': nrm(ks[9], (DEPTH, GMLP_WIDTH), 0.02),
        'w_spatial': nrm(ks[10], (DEPTH, GMLP_GROUPS, CHUNK, CHUNK), CHUNK ** -0.5),
        'b_spatial': 1.0 + nrm(ks[11], (DEPTH, GMLP_GROUPS, CHUNK), 0.02),
        'w_proj_a': nrm(ks[12], (DEPTH, ATTN_OUT_WIDTH, D_MODEL), ATTN_OUT_WIDTH ** -0.5),
        'w_proj_b': nrm(ks[13], (DEPTH, GMLP_WIDTH, D_MODEL), GMLP_WIDTH ** -0.5),
        'w_out': nrm(ks[14], (DEPTH, D_MODEL, D_MODEL), D_MODEL ** -0.5),
        'norm_post': 1.0 + nrm(ks[15], (DEPTH, D_MODEL), 0.02),
    }


def reference(x_prompt, x_sample, cache_kv_w128, cache_kv_w512, cache_kv_w2048, norm_pre, w_in, b_merge, v_norm_g, v_norm_b, w_spatial, b_spatial, w_proj_a, w_proj_b, w_out, norm_post):
    pos_prompt = jnp.arange(x_prompt.shape[1], dtype=jnp.int32)
    pos_sample = PAST_LEN + jnp.arange(x_sample.shape[1], dtype=jnp.int32)
    caches = (cache_kv_w128, cache_kv_w512, cache_kv_w2048)
    xp, xs = x_prompt, x_sample
    kv_p = [[] for _ in ATTN_GROUPS]
    kv_s = [[] for _ in ATTN_GROUPS]
    v_s = []
    for l in range(DEPTH):
        w = (norm_pre[l], w_in[l], b_merge[l], v_norm_g[l], v_norm_b[l], w_spatial[l], b_spatial[l], w_proj_a[l], w_proj_b[l], w_out[l], norm_post[l])
        xp, rows_p, _ = layer_step(xp, pos_prompt, None, *w)
        xs, rows_s, vn_s = layer_step(xs, pos_sample, [c[l] for c in caches], *w)
        for g in range(len(ATTN_GROUPS)):
            kv_p[g].append(rows_p[g])
            kv_s[g].append(rows_s[g])
        v_s.append(vn_s)
    new_kv_w128_prompt = jnp.stack(kv_p[0], axis=0)
    new_kv_w512_prompt = jnp.stack(kv_p[1], axis=0)
    new_kv_w2048_prompt = jnp.stack(kv_p[2], axis=0)
    new_kv_w128_sample = jnp.stack(kv_s[0], axis=0)
    new_kv_w512_sample = jnp.stack(kv_s[1], axis=0)
    new_kv_w2048_sample = jnp.stack(kv_s[2], axis=0)
    new_gmlp_v_sample = jnp.stack(v_s, axis=0)
    return (xp, xs, new_kv_w128_prompt, new_kv_w512_prompt, new_kv_w2048_prompt, new_kv_w128_sample, new_kv_w512_sample, new_kv_w2048_sample, new_gmlp_v_sample)
```

```cpp
#include <hip/hip_runtime.h>
#include <stdint.h>
#include <cstdio>

typedef unsigned short bf16_t;
typedef short bf16x8 __attribute__((ext_vector_type(8)));
typedef float f32x16 __attribute__((ext_vector_type(16)));
typedef float f32x4 __attribute__((ext_vector_type(4)));
typedef unsigned u32x4 __attribute__((ext_vector_type(4)));
#define DI __device__ __forceinline__

constexpr int DM = 1024, BATCH = 8, SEQ = 2048, DEPTH = 4, DECB = 32, PAST = 8192;
constexpr int M = BATCH * SEQ;
constexpr int NIN = 6912;
constexpr int OQ = 0, OKK = 768, OV = 1536, OGA = 2304, OU = 2560, OGV = 3328, OGB = 4096, OGT = 4864;
constexpr float EPS = 1e-6f;
constexpr float C2 = 0.18033688011112042f;
constexpr size_t O_Y = 0, O_YS = 16777216, O_KV128P = 16809984, O_KV512P = 18907136, O_KV2048P = 27295744,
                 O_KV128S = 60850176, O_KV512S = 60915712, O_KV2048S = 60981248, O_VNS = 61046784, O_END = 61145088;
constexpr size_t MiB = 1u << 20;
constexpr size_t WS_CTL = 0, WS_ROPE = 1 * MiB, WS_WIN = 2 * MiB, WS_WPA = 56 * MiB, WS_WPB = 58 * MiB, WS_WOUT = 64 * MiB, WS_WSB = 72 * MiB,
                 WS_XB = 74 * MiB, WS_RSTD = 106 * MiB, WS_ZB = 108 * MiB, WS_AG = 324 * MiB, WS_SG = 332 * MiB, WS_MG = 356 * MiB, WS_Y = 388 * MiB,
                 WS_VN = 452 * MiB, WS_SMP = 480 * MiB, WS_END = 484 * MiB;
constexpr size_t SM_XSB = 0, SM_RSTD = 65536, SM_ZSF = 131072  , SM_AGS = 1048576, SM_SGS = 1048576 + 16384, SM_MGS = 1048576 + 65536,
                 SM_YS = 1048576 + 131072;

struct Params {
    const float* x_prompt; const float* x_sample; const float* cache[3];
    const float* norm_pre; const float* w_in; const float* b_merge; const float* v_norm_g; const float* v_norm_b;
    const float* w_spatial; const float* b_spatial; const float* w_pa; const float* w_pb; const float* w_out; const float* norm_post;
    float* out; unsigned char* ws;
    int phase; int layer;
};

DI float bf2f(bf16_t b) { return __uint_as_float((unsigned)b << 16); }
DI float bfs2f(short b) { return __uint_as_float(((unsigned)(unsigned short)b) << 16); }
DI bf16_t f2bf(float f) { unsigned u = __float_as_uint(f); return (bf16_t)((u + 0x7fffu + ((u >> 16) & 1u)) >> 16); }
DI unsigned pk2(float lo, float hi) { return (unsigned)f2bf(lo) | ((unsigned)f2bf(hi) << 16); }
DI float sigmoidf_(float x) { return 1.0f / (1.0f + __expf(-x)); }
DI float siluf_(float x) { return x * sigmoidf_(x); }
DI float geluf_(float x) { return x * sigmoidf_(1.5957691216057308f * (x + 0.044715f * x * x * x)); }
DI float wave_sum(float v) {
#pragma unroll
    for (int o = 1; o < 64; o <<= 1) v += __shfl_xor(v, o);
    return v;
}
DI float wave_max(float v) {
#pragma unroll
    for (int o = 1; o < 64; o <<= 1) v = fmaxf(v, __shfl_xor(v, o));
    return v;
}
DI int crow(int r, int hi) { return (r & 3) + 8 * (r >> 2) + 4 * hi; }

DI void sincos_d(double a, double& s, double& c) {
    const double TWO_PI = 6.283185307179586476925286766559;
    double n = rint(a / TWO_PI);
    double r = a - n * TWO_PI;
    double x = r * 0.125, x2 = x * x;
    double sv = x * (1.0 + x2 * (-1.0 / 6 + x2 * (1.0 / 120 + x2 * (-1.0 / 5040 + x2 * (1.0 / 362880 + x2 * (-1.0 / 39916800 + x2 * (1.0 / 6227020800.0)))))));
    double cv = 1.0 + x2 * (-0.5 + x2 * (1.0 / 24 + x2 * (-1.0 / 720 + x2 * (1.0 / 40320 + x2 * (-1.0 / 3628800 + x2 * (1.0 / 479001600.0 + x2 * (-1.0 / 87178291200.0)))))));
#pragma unroll
    for (int i = 0; i < 3; ++i) { double s2 = 2.0 * sv * cv, c2 = 1.0 - 2.0 * sv * sv; sv = s2; cv = c2; }
    s = sv; c = cv;
}

DI void transpose_item(const float* W, int K, int N, bf16_t* WT, const float* kscale, float* scr, int item, int lane) {
    const int nblk = N / 32, kb = item / nblk, nb = item % nblk, k0 = 64 * kb, n0 = 32 * nb;
#pragma unroll 8
    for (int i = 0; i < 32; ++i) { const int kk = 2 * i + (lane >> 5); float v = W[(size_t)(k0 + kk) * N + n0 + (lane & 31)]; if (kscale) v *= kscale[k0 + kk]; scr[kk * 33 + (lane & 31)] = v; }
    __builtin_amdgcn_s_waitcnt(0xc07f); asm volatile("" ::: "memory");
    const int c = lane & 7;
#pragma unroll
    for (int j = 0; j < 4; ++j) { const int n = (lane >> 3) + 8 * j; const float* s = scr + (8 * c) * 33 + n;
        u32x4 o; o.x = pk2(s[0 * 33], s[1 * 33]); o.y = pk2(s[2 * 33], s[3 * 33]); o.z = pk2(s[4 * 33], s[5 * 33]); o.w = pk2(s[6 * 33], s[7 * 33]);
        *(u32x4*)(WT + (size_t)(n0 + n) * K + k0 + 8 * c) = o; }
    __builtin_amdgcn_s_waitcnt(0xc07f); asm volatile("" ::: "memory");
}
DI void row_to_bf16(const float* xrow, bf16_t* orow, float* rstd_out, int lane) {
    const f32x4* xr = (const f32x4*)xrow + lane; f32x4 v[4]; float ss = 0.f;
#pragma unroll
    for (int j = 0; j < 4; ++j) { v[j] = xr[64 * j]; ss += (v[j].x * v[j].x + v[j].y * v[j].y) + (v[j].z * v[j].z + v[j].w * v[j].w); }
    ss = wave_sum(ss);
    unsigned long long* o8 = (unsigned long long*)orow + lane;
#pragma unroll
    for (int j = 0; j < 4; ++j) o8[64 * j] = (unsigned long long)pk2(v[j].x, v[j].y) | ((unsigned long long)pk2(v[j].z, v[j].w) << 32);
    if (lane == 0) *rstd_out = 1.0f / sqrtf(ss * (1.0f / DM) + EPS);
}
DI void ph_prologue(const Params& P, float* lds_f, int gw, int ngw, int wave, int lane) {
    unsigned char* ws = P.ws;
    float* scr = lds_f + wave * (64 * 33);
    constexpr int I_IN = (DM / 64) * (NIN / 32), I_PA = (256 / 64) * (DM / 32), I_PB = (768 / 64) * (DM / 32), I_OUT = (DM / 64) * (DM / 32), I_L = I_IN + I_PA + I_PB + I_OUT;
    for (int it = gw; it < DEPTH * I_L; it += ngw) {
        const int l = it / I_L; int r = it % I_L;
        if (r < I_IN) { transpose_item(P.w_in + (size_t)l * DM * NIN, DM, NIN, (bf16_t*)(ws + WS_WIN) + (size_t)l * NIN * DM, P.norm_pre + l * DM, scr, r, lane); continue; } r -= I_IN;
        if (r < I_PA) { transpose_item(P.w_pa + (size_t)l * 256 * DM, 256, DM, (bf16_t*)(ws + WS_WPA) + (size_t)l * DM * 256, nullptr, scr, r, lane); continue; } r -= I_PA;
        if (r < I_PB) { transpose_item(P.w_pb + (size_t)l * 768 * DM, 768, DM, (bf16_t*)(ws + WS_WPB) + (size_t)l * DM * 768, nullptr, scr, r, lane); continue; } r -= I_PB;
        transpose_item(P.w_out + (size_t)l * DM * DM, DM, DM, (bf16_t*)(ws + WS_WOUT) + (size_t)l * DM * DM, nullptr, scr, r, lane);
    }
    { bf16_t* wsb = (bf16_t*)(ws + WS_WSB);
      for (int e = gw * 64 + lane; e < DEPTH * 4 * 128 * 128; e += ngw * 64) { const int j = e & 127, i = (e >> 7) & 127; wsb[e] = (j <= i) ? f2bf(P.w_spatial[e]) : (bf16_t)0; } }
    { float* rc = (float*)(ws + WS_ROPE); float* rs = rc + 2049 * 8;
      for (int e = gw * 64 + lane; e < 2049 * 8; e += ngw * 64) { const int pi = e >> 3, i = e & 7; const float pos = (pi == 2048) ? (float)PAST : (float)pi;
          float fr = 1.0f;
          fr = (i == 1) ? 0.1939227432012558f : fr; fr = (i == 2) ? 0.03760603070259094f : fr; fr = (i == 3) ? 0.007292664609849453f : fr; fr = (i == 4) ? 0.0014142135623842478f : fr;
          fr = (i == 5) ? 0.00027424818836152554f : fr; fr = (i == 6) ? 5.318296098266728e-05f : fr; fr = (i == 7) ? 1.0313386155758053e-05f : fr;
          const float ang = pos * fr; double s, c; sincos_d((double)ang, s, c); rc[e] = (float)c; rs[e] = (float)s; } }
    for (int m = gw; m < M + DECB; m += ngw) {
        if (m < M) row_to_bf16(P.x_prompt + (size_t)m * DM, (bf16_t*)(ws + WS_XB) + (size_t)m * DM, (float*)(ws + WS_RSTD) + m, lane);
        else { const int b = m - M; row_to_bf16(P.x_sample + (size_t)b * DM, (bf16_t*)(ws + WS_SMP + SM_XSB) + (size_t)b * DM, (float*)(ws + WS_SMP + SM_RSTD) + b, lane); }
    }
}

DI f32x16 wave_gemm32(const bf16_t* A, int lda, const bf16_t* Bt, int ldb, int K, int row0, int col0, int lane, f32x16 acc) {
    const int r = lane & 31, h = lane >> 5;
    const bf16_t* ap = A + (size_t)(row0 + r) * lda + 8 * h;
    const bf16_t* bp = Bt + (size_t)(col0 + r) * ldb + 8 * h;
#pragma unroll 4
    for (int k0 = 0; k0 < K; k0 += 16) {
        const bf16x8 a = *(const bf16x8*)(ap + k0), b = *(const bf16x8*)(bp + k0);
        acc = __builtin_amdgcn_mfma_f32_32x32x16_bf16(a, b, acc, 0, 0, 0);
    }
    return acc;
}

DI void g1_epi_scalar(const Params& P, int layer, bool smp, int row, int col, float v, float pv) {
    unsigned char* ws = P.ws;
    float val = v;
    if (col < OV) {
        const int dd = col & 63;
        if (dd < 16) { const int t = smp ? 2048 : (row & (SEQ - 1)); const float* rc = (const float*)(ws + WS_ROPE); const float c = rc[t * 8 + (dd & 7)], s = rc[2049 * 8 + t * 8 + (dd & 7)];
            val = (dd < 8) ? (v * c - pv * s) : (v * c + pv * s); }
        if (col < OKK) val *= C2;
    } else if (col < OGA) {
    } else if (col < OU) val = siluf_(v);
    else if (col < OGB) val = geluf_(v);
    else if (col < OGT) val = siluf_(v);
    else val = sigmoidf_(v + P.b_merge[layer * 2 * DM + (col - OGT)]);
    if (smp) ((float*)(ws + WS_SMP + SM_ZSF))[(size_t)row * NIN + col] = val;
    else ((bf16_t*)(ws + WS_ZB))[(size_t)row * NIN + col] = f2bf(val);
    if (col >= OKK && col < OGA) {
        const int kv = (col >= OV) ? 1 : 0, hh = (col - (kv ? OV : OKK)) >> 6, g = hh >> 2, hs = hh & 3, dd = col & 63;
        if (smp) { const size_t base = (g == 0) ? O_KV128S : (g == 1) ? O_KV512S : O_KV2048S;
            P.out[base + ((size_t)layer * DECB + row) * 512 + kv * 256 + hs * 64 + dd] = val; }
        else { const int keep = 128 << (2 * g), b = row >> 11, t = row & (SEQ - 1), j = t - (SEQ - keep);
            if (j >= 0) { const size_t base = (g == 0) ? O_KV128P : (g == 1) ? O_KV512P : O_KV2048P;
                P.out[base + (((size_t)layer * BATCH + b) * keep + j) * 512 + kv * 256 + hs * 64 + dd] = val; } }
    }
}
DI void g1_wave_tile(const Params& P, int layer, bool smp, int rt, int ct, int lane) {
    unsigned char* ws = P.ws;
    const bf16_t* A = smp ? (const bf16_t*)(ws + WS_SMP + SM_XSB) : (const bf16_t*)(ws + WS_XB);
    const float* rstd = smp ? (const float*)(ws + WS_SMP + SM_RSTD) : (const float*)(ws + WS_RSTD);
    const bf16_t* Bt = (const bf16_t*)(ws + WS_WIN) + (size_t)layer * NIN * DM;
    f32x16 acc = {};
    acc = wave_gemm32(A, DM, Bt, DM, DM, rt * 32, ct * 32, lane, acc);
    const int hi = lane >> 5, col = ct * 32 + (lane & 31);
#pragma unroll
    for (int r = 0; r < 16; ++r) { const int row = rt * 32 + crow(r, hi); const float v = acc[r] * rstd[row]; const float pv = __shfl_xor(v, 8); g1_epi_scalar(P, layer, smp, row, col, v, pv); }
}
DI void ph_g1_naive(const Params& P, int layer, int gw, int ngw, int lane) {
    constexpr int CT = NIN / 32, RT = M / 32;
    for (int it = gw; it < RT * CT + CT; it += ngw) {
        if (it < RT * CT) { const int rt = it / CT, ct = it % CT; g1_wave_tile(P, layer, false, rt, ct, lane); }
        else g1_wave_tile(P, layer, true, 0, it - RT * CT, lane);
    }
}

DI void ph_attn_naive(const Params& P, int layer, int gw, int ngw, int lane) {
    unsigned char* ws = P.ws; const bf16_t* ZB = (const bf16_t*)(ws + WS_ZB); bf16_t* AG = (bf16_t*)(ws + WS_AG);
    for (int item = gw; item < M * 4; item += ngw) {
        const int row = item >> 2, hs = item & 3, t = row & (SEQ - 1), b0 = row - t;
        float m = -INFINITY, l = 0.f, o = 0.f;
        for (int g = 0; g < 3; ++g) {
            const int d = 1 << (2 * g), head = g * 4 + hs;
            const bf16_t* qp = ZB + (size_t)row * NIN + OQ + head * 64;
            bf16x8 qv[8];
#pragma unroll
            for (int i = 0; i < 8; ++i) qv[i] = *(const bf16x8*)(qp + 8 * i);
            for (int jb = 0; jb < 3; ++jb) {
                const int j = jb * 64 + lane, p = t - d * j; const bool valid = (j <= 128) && (p >= 0);
                float s = -INFINITY;
                if (valid) { const bf16_t* kp = ZB + (size_t)(b0 + p) * NIN + OKK + head * 64; float acc = 0.f;
#pragma unroll
                    for (int i = 0; i < 8; ++i) { const bf16x8 kv = *(const bf16x8*)(kp + 8 * i);
#pragma unroll
                        for (int e = 0; e < 8; ++e) acc += bfs2f(qv[i][e]) * bfs2f(kv[e]); }
                    s = acc; }
                const float mx = wave_max(s);
                if (mx == -INFINITY) continue;
                const float mn = fmaxf(m, mx), sc = exp2f(m - mn), pj = valid ? exp2f(s - mn) : 0.f;
                l = l * sc + wave_sum(pj); o *= sc; m = mn;
                const int nj = (129 - jb * 64) < 64 ? (129 - jb * 64) : 64;
                for (int jj = 0; jj < nj; ++jj) { const int pp = t - d * (jb * 64 + jj); if (pp < 0) break;
                    const float pjj = __shfl(pj, jj); o += pjj * bf2f(ZB[(size_t)(b0 + pp) * NIN + OV + head * 64 + lane]); }
            }
        }
        const float gate = bf2f(ZB[(size_t)row * NIN + OGA + hs * 64 + lane]);
        AG[(size_t)row * 256 + hs * 64 + lane] = f2bf(o / l * gate);
    }
}
DI void ph_attn_sample(const Params& P, int layer, int gw, int ngw, int lane) {
    unsigned char* ws = P.ws; const float* ZSF = (const float*)(ws + WS_SMP + SM_ZSF); bf16_t* AGS = (bf16_t*)(ws + WS_SMP + SM_AGS);
    for (int item = gw; item < DECB * 4; item += ngw) {
        const int b = item >> 2, hs = item & 3;
        float m = -INFINITY, l = 0.f, o = 0.f;
        for (int g = 0; g < 3; ++g) {
            const int d = 1 << (2 * g), W = 128 << (2 * g), head = g * 4 + hs;
            const float* cache = P.cache[g] + ((size_t)layer * DECB + b) * W * 512;
            const float* qp = ZSF + (size_t)b * NIN + OQ + head * 64;
            const float* kself = ZSF + (size_t)b * NIN + OKK + head * 64; const float* vself = ZSF + (size_t)b * NIN + OV + head * 64;
            for (int jb = 0; jb < 3; ++jb) {
                const int j = jb * 64 + lane; const bool valid = (j <= 128);
                float s = -INFINITY;
                if (valid) { const float* kp = (j == 0) ? kself : cache + (size_t)(W - d * j) * 512 + hs * 64; float acc = 0.f;
#pragma unroll 8
                    for (int i = 0; i < 64; i += 4) { const f32x4 kk = *(const f32x4*)(kp + i), qq = *(const f32x4*)(qp + i); acc += (kk.x * qq.x + kk.y * qq.y) + (kk.z * qq.z + kk.w * qq.w); }
                    s = acc; }
                const float mx = wave_max(s);
                const float mn = fmaxf(m, mx), sc = exp2f(m - mn), pj = valid ? exp2f(s - mn) : 0.f;
                l = l * sc + wave_sum(pj); o *= sc; m = mn;
                const int nj = (129 - jb * 64) < 64 ? (129 - jb * 64) : 64;
                for (int jj = 0; jj < nj; ++jj) { const int jg = jb * 64 + jj; const float* vp = (jg == 0) ? vself : cache + (size_t)(W - d * jg) * 512 + 256 + hs * 64;
                    o += __shfl(pj, jj) * vp[lane]; }
            }
        }
        const float gate = ZSF[(size_t)b * NIN + OGA + hs * 64 + lane];
        AGS[b * 256 + hs * 64 + lane] = f2bf(o / l * gate);
    }
}

DI void ph_gmlp_naive(const Params& P, int layer, int wg, int nwg, int tid, int nthreads) {
    unsigned char* ws = P.ws; const bf16_t* ZB = (const bf16_t*)(ws + WS_ZB); bf16_t* VN = (bf16_t*)(ws + WS_VN); bf16_t* SG = (bf16_t*)(ws + WS_SG);
    const bf16_t* WSB = (const bf16_t*)(ws + WS_WSB) + (size_t)layer * 4 * 128 * 128;
    const float* lg = P.v_norm_g + layer * 768; const float* lb = P.v_norm_b + layer * 768; const float* bsp = P.b_spatial + layer * 4 * 128;
    const int wave = tid >> 6, lane = tid & 63, nwaves = nthreads >> 6;
    for (int ch = wg; ch < M / 128; ch += nwg) {
        const int r0 = ch * 128;
        for (int r = wave; r < 128; r += nwaves) {
            const bf16_t* gp = ZB + (size_t)(r0 + r) * NIN + OGV; float x[12]; float s = 0.f;
#pragma unroll
            for (int i = 0; i < 12; ++i) { x[i] = bf2f(gp[i * 64 + lane]); s += x[i]; }
            const float mean = wave_sum(s) * (1.0f / 768); float q = 0.f;
#pragma unroll
            for (int i = 0; i < 12; ++i) { x[i] -= mean; q += x[i] * x[i]; }
            const float rs = 1.0f / sqrtf(wave_sum(q) * (1.0f / 768) + EPS);
#pragma unroll
            for (int i = 0; i < 12; ++i) { const int c = i * 64 + lane; VN[(size_t)(r0 + r) * 768 + c] = f2bf(x[i] * rs * lg[c] + lb[c]); }
        }
        __threadfence_block();
        __syncthreads();
        for (int e = tid; e < 128 * 768; e += nthreads) {
            const int i = e / 768, c = e % 768, g = c / 192; const bf16_t* wrow = WSB + (g * 128 + i) * 128; float acc = 0.f;
            for (int j = 0; j <= i; ++j) acc += bf2f(wrow[j]) * bf2f(VN[(size_t)(r0 + j) * 768 + c]);
            const float mix = acc + bsp[g * 128 + i];
            const size_t zr = (size_t)(r0 + i) * NIN;
            SG[(size_t)(r0 + i) * 768 + c] = f2bf(bf2f(ZB[zr + OU + c]) * mix * bf2f(ZB[zr + OGB + c]));
        }
        __syncthreads();
    }
}
DI void ph_gmlp_sample(const Params& P, int layer, int gw, int ngw, int lane) {
    unsigned char* ws = P.ws; const float* ZSF = (const float*)(ws + WS_SMP + SM_ZSF); bf16_t* SGS = (bf16_t*)(ws + WS_SMP + SM_SGS);
    const float* lg = P.v_norm_g + layer * 768; const float* lb = P.v_norm_b + layer * 768;
    for (int b = gw; b < DECB; b += ngw) {
        const float* z = ZSF + (size_t)b * NIN; float x[12]; float s = 0.f;
#pragma unroll
        for (int i = 0; i < 12; ++i) { x[i] = z[OGV + i * 64 + lane]; s += x[i]; }
        const float mean = wave_sum(s) * (1.0f / 768); float q = 0.f;
#pragma unroll
        for (int i = 0; i < 12; ++i) { x[i] -= mean; q += x[i] * x[i]; }
        const float rs = 1.0f / sqrtf(wave_sum(q) * (1.0f / 768) + EPS);
#pragma unroll
        for (int i = 0; i < 12; ++i) { const int c = i * 64 + lane, g = c / 192; const float vn = x[i] * rs * lg[c] + lb[c];
            P.out[O_VNS + ((size_t)layer * DECB + b) * 768 + c] = vn;
            const float mix = P.w_spatial[((size_t)layer * 4 + g) * 128 * 128] * vn + P.b_spatial[(layer * 4 + g) * 128];
            SGS[b * 768 + c] = f2bf(z[OU + c] * mix * z[OGB + c]); }
    }
}

DI void g2_wave_tile(const Params& P, int layer, bool smp, int rt, int ct, int lane) {
    unsigned char* ws = P.ws;
    const bf16_t* AGp = smp ? (const bf16_t*)(ws + WS_SMP + SM_AGS) : (const bf16_t*)(ws + WS_AG);
    const bf16_t* SGp = smp ? (const bf16_t*)(ws + WS_SMP + SM_SGS) : (const bf16_t*)(ws + WS_SG);
    bf16_t* MGp = smp ? (bf16_t*)(ws + WS_SMP + SM_MGS) : (bf16_t*)(ws + WS_MG);
    f32x16 a = {}, b = {};
    a = wave_gemm32(AGp, 256, (const bf16_t*)(ws + WS_WPA) + (size_t)layer * DM * 256, 256, 256, rt * 32, ct * 32, lane, a);
    b = wave_gemm32(SGp, 768, (const bf16_t*)(ws + WS_WPB) + (size_t)layer * DM * 768, 768, 768, rt * 32, ct * 32, lane, b);
    const int hi = lane >> 5, col = ct * 32 + (lane & 31);
#pragma unroll
    for (int r = 0; r < 16; ++r) { const int row = rt * 32 + crow(r, hi); float ga, gb;
        if (smp) { const float* z = (const float*)(ws + WS_SMP + SM_ZSF) + (size_t)row * NIN + OGT; ga = z[col]; gb = z[DM + col]; }
        else { const bf16_t* z = (const bf16_t*)(ws + WS_ZB) + (size_t)row * NIN + OGT; ga = bf2f(z[col]); gb = bf2f(z[DM + col]); }
        MGp[(size_t)row * DM + col] = f2bf(ga * a[r] + gb * b[r]); }
}
DI void ph_g2_naive(const Params& P, int layer, int gw, int ngw, int lane) {
    constexpr int CT = DM / 32, RT = M / 32;
    for (int it = gw; it < RT * CT + CT; it += ngw) {
        if (it < RT * CT) g2_wave_tile(P, layer, false, it / CT, it % CT, lane); else g2_wave_tile(P, layer, true, 0, it - RT * CT, lane);
    }
}
DI void g3_wave_tile(const Params& P, int layer, bool smp, int rt, int ct, int lane) {
    unsigned char* ws = P.ws;
    const bf16_t* MGp = smp ? (const bf16_t*)(ws + WS_SMP + SM_MGS) : (const bf16_t*)(ws + WS_MG);
    float* Yp = smp ? (float*)(ws + WS_SMP + SM_YS) : (float*)(ws + WS_Y);
    f32x16 a = {};
    a = wave_gemm32(MGp, DM, (const bf16_t*)(ws + WS_WOUT) + (size_t)layer * DM * DM, DM, DM, rt * 32, ct * 32, lane, a);
    const int hi = lane >> 5, col = ct * 32 + (lane & 31);
#pragma unroll
    for (int r = 0; r < 16; ++r) Yp[(size_t)(rt * 32 + crow(r, hi)) * DM + col] = a[r];
}
DI void ph_g3_naive(const Params& P, int layer, int gw, int ngw, int lane) {
    constexpr int CT = DM / 32, RT = M / 32;
    for (int it = gw; it < RT * CT + CT; it += ngw) {
        if (it < RT * CT) g3_wave_tile(P, layer, false, it / CT, it % CT, lane); else g3_wave_tile(P, layer, true, 0, it - RT * CT, lane);
    }
}
DI void post_row(const float* xin, const float* y, const float* gpost, float* xout, bf16_t* xb, float* rstd_out, int lane) {
    const f32x4* yr = (const f32x4*)y + lane; const f32x4* xr = (const f32x4*)xin + lane; const f32x4* gr = (const f32x4*)gpost + lane;
    f32x4 v[4]; float ss = 0.f;
#pragma unroll
    for (int j = 0; j < 4; ++j) { v[j] = yr[64 * j]; ss += (v[j].x * v[j].x + v[j].y * v[j].y) + (v[j].z * v[j].z + v[j].w * v[j].w); }
    const float rs = 1.0f / sqrtf(wave_sum(ss) * (1.0f / DM) + EPS);
    float s2 = 0.f;
#pragma unroll
    for (int j = 0; j < 4; ++j) { const f32x4 x = xr[64 * j], g = gr[64 * j]; v[j] = x + v[j] * rs * g; s2 += (v[j].x * v[j].x + v[j].y * v[j].y) + (v[j].z * v[j].z + v[j].w * v[j].w); }
    s2 = wave_sum(s2);
    f32x4* xo = (f32x4*)xout + lane; unsigned long long* o8 = (unsigned long long*)xb + lane;
#pragma unroll
    for (int j = 0; j < 4; ++j) { xo[64 * j] = v[j]; o8[64 * j] = (unsigned long long)pk2(v[j].x, v[j].y) | ((unsigned long long)pk2(v[j].z, v[j].w) << 32); }
    if (lane == 0) *rstd_out = 1.0f / sqrtf(s2 * (1.0f / DM) + EPS);
}
DI void ph_post(const Params& P, int layer, int gw, int ngw, int lane) {
    unsigned char* ws = P.ws; const float* gpost = P.norm_post + layer * DM;
    for (int m = gw; m < M + DECB; m += ngw) {
        if (m < M) { const float* xin = (layer == 0) ? P.x_prompt + (size_t)m * DM : P.out + O_Y + (size_t)m * DM;
            post_row(xin, (const float*)(ws + WS_Y) + (size_t)m * DM, gpost, P.out + O_Y + (size_t)m * DM, (bf16_t*)(ws + WS_XB) + (size_t)m * DM, (float*)(ws + WS_RSTD) + m, lane); }
        else { const int b = m - M; const float* xin = (layer == 0) ? P.x_sample + (size_t)b * DM : P.out + O_YS + (size_t)b * DM;
            post_row(xin, (const float*)(ws + WS_SMP + SM_YS) + (size_t)b * DM, gpost, P.out + O_YS + (size_t)b * DM, (bf16_t*)(ws + WS_SMP + SM_XSB) + (size_t)b * DM, (float*)(ws + WS_SMP + SM_RSTD) + b, lane); }
    }
}

constexpr int NT = 512;
constexpr int LDS_BYTES = 8 * 64 * 33 * 4;
__global__ void __launch_bounds__(NT) stage_kernel(Params P) {
    extern __shared__ __attribute__((aligned(16))) unsigned char lds[];
    const int tid = threadIdx.x, lane = tid & 63, wave = tid >> 6;
    const int gw = blockIdx.x * (NT / 64) + wave, ngw = gridDim.x * (NT / 64);
    const int L = P.layer;
    switch (P.phase) {
        case 0: ph_prologue(P, (float*)lds, gw, ngw, wave, lane); break;
        case 1: ph_g1_naive(P, L, gw, ngw, lane); break;
        case 2: ph_attn_naive(P, L, gw, ngw, lane); ph_attn_sample(P, L, gw, ngw, lane); ph_gmlp_sample(P, L, ngw - 1 - gw, ngw, lane); break;
        case 3: ph_gmlp_naive(P, L, blockIdx.x, gridDim.x, tid, NT); break;
        case 4: ph_g2_naive(P, L, gw, ngw, lane); break;
        case 5: ph_g3_naive(P, L, gw, ngw, lane); break;
        case 6: ph_post(P, L, gw, ngw, lane); break;
    }
}

extern "C" void kernel_launch(void* const* d_in, const int* in_sizes, int n_in, void* d_out, int out_size, void* d_ws, size_t ws_size, hipStream_t stream) {
    if (n_in != 16 || (size_t)out_size != O_END || ws_size < WS_END) { fprintf(stderr, "kernel_launch: unexpected shapes n_in %d out %d ws %zu\n", n_in, out_size, ws_size); return; }
    Params P{};
    P.x_prompt = (const float*)d_in[0]; P.x_sample = (const float*)d_in[1]; P.cache[0] = (const float*)d_in[2]; P.cache[1] = (const float*)d_in[3]; P.cache[2] = (const float*)d_in[4];
    P.norm_pre = (const float*)d_in[5]; P.w_in = (const float*)d_in[6]; P.b_merge = (const float*)d_in[7]; P.v_norm_g = (const float*)d_in[8]; P.v_norm_b = (const float*)d_in[9];
    P.w_spatial = (const float*)d_in[10]; P.b_spatial = (const float*)d_in[11]; P.w_pa = (const float*)d_in[12]; P.w_pb = (const float*)d_in[13]; P.w_out = (const float*)d_in[14]; P.norm_post = (const float*)d_in[15];
    P.out = (float*)d_out; P.ws = (unsigned char*)d_ws;
    const int grid = 1024;
    (void)hipFuncSetAttribute((const void*)stage_kernel, hipFuncAttributeMaxDynamicSharedMemorySize, LDS_BYTES);
    P.phase = 0; P.layer = 0; hipLaunchKernelGGL(stage_kernel, dim3(grid), dim3(NT), LDS_BYTES, stream, P);
    for (int l = 0; l < DEPTH; ++l) {
        P.layer = l;
        for (int ph = 1; ph <= 6; ++ph) { P.phase = ph; hipLaunchKernelGGL(stage_kernel, dim3(grid), dim3(NT), LDS_BYTES, stream, P); }
    }
}
```

```cpp
#include <hip/hip_runtime.h>
#include <stdint.h>
#include <cstdio>

typedef unsigned short bf16_t;
typedef short bf16x8 __attribute__((ext_vector_type(8)));
typedef float f32x16 __attribute__((ext_vector_type(16)));
typedef float f32x4 __attribute__((ext_vector_type(4)));
typedef unsigned u32x4 __attribute__((ext_vector_type(4)));
#define DI __device__ __forceinline__

constexpr int DM = 1024, BATCH = 8, SEQ = 2048, DEPTH = 4, DECB = 32, PAST = 8192;
constexpr int M = BATCH * SEQ;
constexpr int NIN = 6912;
constexpr int OQ = 0, OKK = 768, OV = 1536, OGA = 2304, OU = 2560, OGV = 3328, OGB = 4096, OGT = 4864;
constexpr float EPS = 1e-6f;
constexpr float C2 = 0.18033688011112042f;
constexpr size_t O_Y = 0, O_YS = 16777216, O_KV128P = 16809984, O_KV512P = 18907136, O_KV2048P = 27295744,
                 O_KV128S = 60850176, O_KV512S = 60915712, O_KV2048S = 60981248, O_VNS = 61046784, O_END = 61145088;
constexpr size_t MiB = 1u << 20;
constexpr size_t WS_CTL = 0, WS_ROPE = 1 * MiB, WS_WIN = 2 * MiB, WS_WPA = 56 * MiB, WS_WPB = 58 * MiB, WS_WOUT = 64 * MiB, WS_WSB = 72 * MiB,
                 WS_XB = 74 * MiB, WS_RSTD = 106 * MiB, WS_ZB = 108 * MiB, WS_AG = 324 * MiB, WS_SG = 332 * MiB, WS_MG = 356 * MiB, WS_Y = 388 * MiB,
                 WS_VN = 452 * MiB, WS_SMP = 480 * MiB, WS_END = 484 * MiB;
constexpr size_t SM_XSB = 0, SM_RSTD = 65536, SM_ZSF = 131072  , SM_AGS = 1048576, SM_SGS = 1048576 + 16384, SM_MGS = 1048576 + 65536,
                 SM_YS = 1048576 + 131072;

struct Params {
    const float* x_prompt; const float* x_sample; const float* cache[3];
    const float* norm_pre; const float* w_in; const float* b_merge; const float* v_norm_g; const float* v_norm_b;
    const float* w_spatial; const float* b_spatial; const float* w_pa; const float* w_pb; const float* w_out; const float* norm_post;
    float* out; unsigned char* ws;
    int phase; int layer;
};

DI float bf2f(bf16_t b) { return __uint_as_float((unsigned)b << 16); }
DI float bfs2f(short b) { return __uint_as_float(((unsigned)(unsigned short)b) << 16); }
DI bf16_t f2bf(float f) { unsigned u = __float_as_uint(f); return (bf16_t)((u + 0x7fffu + ((u >> 16) & 1u)) >> 16); }
DI unsigned pk2(float lo, float hi) { return (unsigned)f2bf(lo) | ((unsigned)f2bf(hi) << 16); }
DI float sigmoidf_(float x) { return 1.0f / (1.0f + __expf(-x)); }
DI float siluf_(float x) { return x * sigmoidf_(x); }
DI float geluf_(float x) { return x * sigmoidf_(1.5957691216057308f * (x + 0.044715f * x * x * x)); }
DI float wave_sum(float v) {
#pragma unroll
    for (int o = 1; o < 64; o <<= 1) v += __shfl_xor(v, o);
    return v;
}
DI float wave_max(float v) {
#pragma unroll
    for (int o = 1; o < 64; o <<= 1) v = fmaxf(v, __shfl_xor(v, o));
    return v;
}
DI int crow(int r, int hi) { return (r & 3) + 8 * (r >> 2) + 4 * hi; }

DI void sincos_d(double a, double& s, double& c) {
    const double TWO_PI = 6.283185307179586476925286766559;
    double n = rint(a / TWO_PI);
    double r = a - n * TWO_PI;
    double x = r * 0.125, x2 = x * x;
    double sv = x * (1.0 + x2 * (-1.0 / 6 + x2 * (1.0 / 120 + x2 * (-1.0 / 5040 + x2 * (1.0 / 362880 + x2 * (-1.0 / 39916800 + x2 * (1.0 / 6227020800.0)))))));
    double cv = 1.0 + x2 * (-0.5 + x2 * (1.0 / 24 + x2 * (-1.0 / 720 + x2 * (1.0 / 40320 + x2 * (-1.0 / 3628800 + x2 * (1.0 / 479001600.0 + x2 * (-1.0 / 87178291200.0)))))));
#pragma unroll
    for (int i = 0; i < 3; ++i) { double s2 = 2.0 * sv * cv, c2 = 1.0 - 2.0 * sv * sv; sv = s2; cv = c2; }
    s = sv; c = cv;
}

DI void transpose_item(const float* W, int K, int N, bf16_t* WT, const float* kscale, float* scr, int item, int lane) {
    const int nblk = N / 32, kb = item / nblk, nb = item % nblk, k0 = 64 * kb, n0 = 32 * nb;
#pragma unroll 8
    for (int i = 0; i < 32; ++i) { const int kk = 2 * i + (lane >> 5); float v = W[(size_t)(k0 + kk) * N + n0 + (lane & 31)]; if (kscale) v *= kscale[k0 + kk]; scr[kk * 33 + (lane & 31)] = v; }
    __builtin_amdgcn_s_waitcnt(0xc07f); asm volatile("" ::: "memory");
    const int c = lane & 7;
#pragma unroll
    for (int j = 0; j < 4; ++j) { const int n = (lane >> 3) + 8 * j; const float* s = scr + (8 * c) * 33 + n;
        u32x4 o; o.x = pk2(s[0 * 33], s[1 * 33]); o.y = pk2(s[2 * 33], s[3 * 33]); o.z = pk2(s[4 * 33], s[5 * 33]); o.w = pk2(s[6 * 33], s[7 * 33]);
        *(u32x4*)(WT + (size_t)(n0 + n) * K + k0 + 8 * c) = o; }
    __builtin_amdgcn_s_waitcnt(0xc07f); asm volatile("" ::: "memory");
}
DI void row_to_bf16(const float* xrow, bf16_t* orow, float* rstd_out, int lane) {
    const f32x4* xr = (const f32x4*)xrow + lane; f32x4 v[4]; float ss = 0.f;
#pragma unroll
    for (int j = 0; j < 4; ++j) { v[j] = xr[64 * j]; ss += (v[j].x * v[j].x + v[j].y * v[j].y) + (v[j].z * v[j].z + v[j].w * v[j].w); }
    ss = wave_sum(ss);
    unsigned long long* o8 = (unsigned long long*)orow + lane;
#pragma unroll
    for (int j = 0; j < 4; ++j) o8[64 * j] = (unsigned long long)pk2(v[j].x, v[j].y) | ((unsigned long long)pk2(v[j].z, v[j].w) << 32);
    if (lane == 0) *rstd_out = 1.0f / sqrtf(ss * (1.0f / DM) + EPS);
}
DI void ph_prologue(const Params& P, float* lds_f, int gw, int ngw, int wave, int lane) {
    unsigned char* ws = P.ws;
    float* scr = lds_f + wave * (64 * 33);
    constexpr int I_IN = (DM / 64) * (NIN / 32), I_PA = (256 / 64) * (DM / 32), I_PB = (768 / 64) * (DM / 32), I_OUT = (DM / 64) * (DM / 32), I_L = I_IN + I_PA + I_PB + I_OUT;
    for (int it = gw; it < DEPTH * I_L; it += ngw) {
        const int l = it / I_L; int r = it % I_L;
        if (r < I_IN) { transpose_item(P.w_in + (size_t)l * DM * NIN, DM, NIN, (bf16_t*)(ws + WS_WIN) + (size_t)l * NIN * DM, P.norm_pre + l * DM, scr, r, lane); continue; } r -= I_IN;
        if (r < I_PA) { transpose_item(P.w_pa + (size_t)l * 256 * DM, 256, DM, (bf16_t*)(ws + WS_WPA) + (size_t)l * DM * 256, nullptr, scr, r, lane); continue; } r -= I_PA;
        if (r < I_PB) { transpose_item(P.w_pb + (size_t)l * 768 * DM, 768, DM, (bf16_t*)(ws + WS_WPB) + (size_t)l * DM * 768, nullptr, scr, r, lane); continue; } r -= I_PB;
        transpose_item(P.w_out + (size_t)l * DM * DM, DM, DM, (bf16_t*)(ws + WS_WOUT) + (size_t)l * DM * DM, nullptr, scr, r, lane);
    }
    { bf16_t* wsb = (bf16_t*)(ws + WS_WSB);
      for (int e = gw * 64 + lane; e < DEPTH * 4 * 128 * 128; e += ngw * 64) { const int j = e & 127, i = (e >> 7) & 127; wsb[e] = (j <= i) ? f2bf(P.w_spatial[e]) : (bf16_t)0; } }
    { float* rc = (float*)(ws + WS_ROPE); float* rs = rc + 2049 * 8;
      for (int e = gw * 64 + lane; e < 2049 * 8; e += ngw * 64) { const int pi = e >> 3, i = e & 7; const float pos = (pi == 2048) ? (float)PAST : (float)pi;
          float fr = 1.0f;
          fr = (i == 1) ? 0.1939227432012558f : fr; fr = (i == 2) ? 0.03760603070259094f : fr; fr = (i == 3) ? 0.007292664609849453f : fr; fr = (i == 4) ? 0.0014142135623842478f : fr;
          fr = (i == 5) ? 0.00027424818836152554f : fr; fr = (i == 6) ? 5.318296098266728e-05f : fr; fr = (i == 7) ? 1.0313386155758053e-05f : fr;
          const float ang = pos * fr; double s, c; sincos_d((double)ang, s, c); rc[e] = (float)c; rs[e] = (float)s; } }
    for (int m = gw; m < M + DECB; m += ngw) {
        if (m < M) row_to_bf16(P.x_prompt + (size_t)m * DM, (bf16_t*)(ws + WS_XB) + (size_t)m * DM, (float*)(ws + WS_RSTD) + m, lane);
        else { const int b = m - M; row_to_bf16(P.x_sample + (size_t)b * DM, (bf16_t*)(ws + WS_SMP + SM_XSB) + (size_t)b * DM, (float*)(ws + WS_SMP + SM_RSTD) + b, lane); }
    }
}

DI f32x16 wave_gemm32(const bf16_t* A, int lda, const bf16_t* Bt, int ldb, int K, int row0, int col0, int lane, f32x16 acc) {
    const int r = lane & 31, h = lane >> 5;
    const bf16_t* ap = A + (size_t)(row0 + r) * lda + 8 * h;
    const bf16_t* bp = Bt + (size_t)(col0 + r) * ldb + 8 * h;
#pragma unroll 4
    for (int k0 = 0; k0 < K; k0 += 16) {
        const bf16x8 a = *(const bf16x8*)(ap + k0), b = *(const bf16x8*)(bp + k0);
        acc = __builtin_amdgcn_mfma_f32_32x32x16_bf16(a, b, acc, 0, 0, 0);
    }
    return acc;
}

DI void g1_epi_scalar(const Params& P, int layer, bool smp, int row, int col, float v, float pv) {
    unsigned char* ws = P.ws;
    float val = v;
    if (col < OV) {
        const int dd = col & 63;
        if (dd < 16) { const int t = smp ? 2048 : (row & (SEQ - 1)); const float* rc = (const float*)(ws + WS_ROPE); const float c = rc[t * 8 + (dd & 7)], s = rc[2049 * 8 + t * 8 + (dd & 7)];
            val = (dd < 8) ? (v * c - pv * s) : (v * c + pv * s); }
        if (col < OKK) val *= C2;
    } else if (col < OGA) {
    } else if (col < OU) val = siluf_(v);
    else if (col < OGB) val = geluf_(v);
    else if (col < OGT) val = siluf_(v);
    else val = sigmoidf_(v + P.b_merge[layer * 2 * DM + (col - OGT)]);
    if (smp) ((float*)(ws + WS_SMP + SM_ZSF))[(size_t)row * NIN + col] = val;
    else ((bf16_t*)(ws + WS_ZB))[(size_t)row * NIN + col] = f2bf(val);
    if (col >= OKK && col < OGA) {
        const int kv = (col >= OV) ? 1 : 0, hh = (col - (kv ? OV : OKK)) >> 6, g = hh >> 2, hs = hh & 3, dd = col & 63;
        if (smp) { const size_t base = (g == 0) ? O_KV128S : (g == 1) ? O_KV512S : O_KV2048S;
            P.out[base + ((size_t)layer * DECB + row) * 512 + kv * 256 + hs * 64 + dd] = val; }
        else { const int keep = 128 << (2 * g), b = row >> 11, t = row & (SEQ - 1), j = t - (SEQ - keep);
            if (j >= 0) { const size_t base = (g == 0) ? O_KV128P : (g == 1) ? O_KV512P : O_KV2048P;
                P.out[base + (((size_t)layer * BATCH + b) * keep + j) * 512 + kv * 256 + hs * 64 + dd] = val; } }
    }
}
DI void g1_wave_tile(const Params& P, int layer, bool smp, int rt, int ct, int lane) {
    unsigned char* ws = P.ws;
    const bf16_t* A = smp ? (const bf16_t*)(ws + WS_SMP + SM_XSB) : (const bf16_t*)(ws + WS_XB);
    const float* rstd = smp ? (const float*)(ws + WS_SMP + SM_RSTD) : (const float*)(ws + WS_RSTD);
    const bf16_t* Bt = (const bf16_t*)(ws + WS_WIN) + (size_t)layer * NIN * DM;
    f32x16 acc = {};
    acc = wave_gemm32(A, DM, Bt, DM, DM, rt * 32, ct * 32, lane, acc);
    const int hi = lane >> 5, col = ct * 32 + (lane & 31);
#pragma unroll
    for (int r = 0; r < 16; ++r) { const int row = rt * 32 + crow(r, hi); const float v = acc[r] * rstd[row]; const float pv = __shfl_xor(v, 8); g1_epi_scalar(P, layer, smp, row, col, v, pv); }
}
DI void ph_g1_naive(const Params& P, int layer, int gw, int ngw, int lane) {
    constexpr int CT = NIN / 32, RT = M / 32;
    for (int it = gw; it < RT * CT + CT; it += ngw) {
        if (it < RT * CT) { const int rt = it / CT, ct = it % CT; g1_wave_tile(P, layer, false, rt, ct, lane); }
        else g1_wave_tile(P, layer, true, 0, it - RT * CT, lane);
    }
}

DI void ph_attn_naive(const Params& P, int layer, int gw, int ngw, int lane) {
    unsigned char* ws = P.ws; const bf16_t* ZB = (const bf16_t*)(ws + WS_ZB); bf16_t* AG = (bf16_t*)(ws + WS_AG);
    for (int item = gw; item < M * 4; item += ngw) {
        const int row = item >> 2, hs = item & 3, t = row & (SEQ - 1), b0 = row - t;
        float m = -INFINITY, l = 0.f, o = 0.f;
        for (int g = 0; g < 3; ++g) {
            const int d = 1 << (2 * g), head = g * 4 + hs;
            const bf16_t* qp = ZB + (size_t)row * NIN + OQ + head * 64;
            bf16x8 qv[8];
#pragma unroll
            for (int i = 0; i < 8; ++i) qv[i] = *(const bf16x8*)(qp + 8 * i);
            for (int jb = 0; jb < 3; ++jb) {
                const int j = jb * 64 + lane, p = t - d * j; const bool valid = (j <= 128) && (p >= 0);
                float s = -INFINITY;
                if (valid) { const bf16_t* kp = ZB + (size_t)(b0 + p) * NIN + OKK + head * 64; float acc = 0.f;
#pragma unroll
                    for (int i = 0; i < 8; ++i) { const bf16x8 kv = *(const bf16x8*)(kp + 8 * i);
#pragma unroll
                        for (int e = 0; e < 8; ++e) acc += bfs2f(qv[i][e]) * bfs2f(kv[e]); }
                    s = acc; }
                const float mx = wave_max(s);
                if (mx == -INFINITY) continue;
                const float mn = fmaxf(m, mx), sc = exp2f(m - mn), pj = valid ? exp2f(s - mn) : 0.f;
                l = l * sc + wave_sum(pj); o *= sc; m = mn;
                const int nj = (129 - jb * 64) < 64 ? (129 - jb * 64) : 64;
                for (int jj = 0; jj < nj; ++jj) { const int pp = t - d * (jb * 64 + jj); if (pp < 0) break;
                    const float pjj = __shfl(pj, jj); o += pjj * bf2f(ZB[(size_t)(b0 + pp) * NIN + OV + head * 64 + lane]); }
            }
        }
        const float gate = bf2f(ZB[(size_t)row * NIN + OGA + hs * 64 + lane]);
        AG[(size_t)row * 256 + hs * 64 + lane] = f2bf(o / l * gate);
    }
}
DI void ph_attn_sample(const Params& P, int layer, int gw, int ngw, int lane) {
    unsigned char* ws = P.ws; const float* ZSF = (const float*)(ws + WS_SMP + SM_ZSF); bf16_t* AGS = (bf16_t*)(ws + WS_SMP + SM_AGS);
    for (int item = gw; item < DECB * 4; item += ngw) {
        const int b = item >> 2, hs = item & 3;
        float m = -INFINITY, l = 0.f, o = 0.f;
        for (int g = 0; g < 3; ++g) {
            const int d = 1 << (2 * g), W = 128 << (2 * g), head = g * 4 + hs;
            const float* cache = P.cache[g] + ((size_t)layer * DECB + b) * W * 512;
            const float* qp = ZSF + (size_t)b * NIN + OQ + head * 64;
            const float* kself = ZSF + (size_t)b * NIN + OKK + head * 64; const float* vself = ZSF + (size_t)b * NIN + OV + head * 64;
            for (int jb = 0; jb < 3; ++jb) {
                const int j = jb * 64 + lane; const bool valid = (j <= 128);
                float s = -INFINITY;
                if (valid) { const float* kp = (j == 0) ? kself : cache + (size_t)(W - d * j) * 512 + hs * 64; float acc = 0.f;
#pragma unroll 8
                    for (int i = 0; i < 64; i += 4) { const f32x4 kk = *(const f32x4*)(kp + i), qq = *(const f32x4*)(qp + i); acc += (kk.x * qq.x + kk.y * qq.y) + (kk.z * qq.z + kk.w * qq.w); }
                    s = acc; }
                const float mx = wave_max(s);
                const float mn = fmaxf(m, mx), sc = exp2f(m - mn), pj = valid ? exp2f(s - mn) : 0.f;
                l = l * sc + wave_sum(pj); o *= sc; m = mn;
                const int nj = (129 - jb * 64) < 64 ? (129 - jb * 64) : 64;
                for (int jj = 0; jj < nj; ++jj) { const int jg = jb * 64 + jj; const float* vp = (jg == 0) ? vself : cache + (size_t)(W - d * jg) * 512 + 256 + hs * 64;
                    o += __shfl(pj, jj) * vp[lane]; }
            }
        }
        const float gate = ZSF[(size_t)b * NIN + OGA + hs * 64 + lane];
        AGS[b * 256 + hs * 64 + lane] = f2bf(o / l * gate);
    }
}

DI void ph_gmlp_naive(const Params& P, int layer, int wg, int nwg, int tid, int nthreads) {
    unsigned char* ws = P.ws; const bf16_t* ZB = (const bf16_t*)(ws + WS_ZB); bf16_t* VN = (bf16_t*)(ws + WS_VN); bf16_t* SG = (bf16_t*)(ws + WS_SG);
    const bf16_t* WSB = (const bf16_t*)(ws + WS_WSB) + (size_t)layer * 4 * 128 * 128;
    const float* lg = P.v_norm_g + layer * 768; const float* lb = P.v_norm_b + layer * 768; const float* bsp = P.b_spatial + layer * 4 * 128;
    const int wave = tid >> 6, lane = tid & 63, nwaves = nthreads >> 6;
    for (int ch = wg; ch < M / 128; ch += nwg) {
        const int r0 = ch * 128;
        for (int r = wave; r < 128; r += nwaves) {
            const bf16_t* gp = ZB + (size_t)(r0 + r) * NIN + OGV; float x[12]; float s = 0.f;
#pragma unroll
            for (int i = 0; i < 12; ++i) { x[i] = bf2f(gp[i * 64 + lane]); s += x[i]; }
            const float mean = wave_sum(s) * (1.0f / 768); float q = 0.f;
#pragma unroll
            for (int i = 0; i < 12; ++i) { x[i] -= mean; q += x[i] * x[i]; }
            const float rs = 1.0f / sqrtf(wave_sum(q) * (1.0f / 768) + EPS);
#pragma unroll
            for (int i = 0; i < 12; ++i) { const int c = i * 64 + lane; VN[(size_t)(r0 + r) * 768 + c] = f2bf(x[i] * rs * lg[c] + lb[c]); }
        }
        __threadfence_block();
        __syncthreads();
        for (int e = tid; e < 128 * 768; e += nthreads) {
            const int i = e / 768, c = e % 768, g = c / 192; const bf16_t* wrow = WSB + (g * 128 + i) * 128; float acc = 0.f;
            for (int j = 0; j <= i; ++j) acc += bf2f(wrow[j]) * bf2f(VN[(size_t)(r0 + j) * 768 + c]);
            const float mix = acc + bsp[g * 128 + i];
            const size_t zr = (size_t)(r0 + i) * NIN;
            SG[(size_t)(r0 + i) * 768 + c] = f2bf(bf2f(ZB[zr + OU + c]) * mix * bf2f(ZB[zr + OGB + c]));
        }
        __syncthreads();
    }
}
DI void ph_gmlp_sample(const Params& P, int layer, int gw, int ngw, int lane) {
    unsigned char* ws = P.ws; const float* ZSF = (const float*)(ws + WS_SMP + SM_ZSF); bf16_t* SGS = (bf16_t*)(ws + WS_SMP + SM_SGS);
    const float* lg = P.v_norm_g + layer * 768; const float* lb = P.v_norm_b + layer * 768;
    for (int b = gw; b < DECB; b += ngw) {
        const float* z = ZSF + (size_t)b * NIN; float x[12]; float s = 0.f;
#pragma unroll
        for (int i = 0; i < 12; ++i) { x[i] = z[OGV + i * 64 + lane]; s += x[i]; }
        const float mean = wave_sum(s) * (1.0f / 768); float q = 0.f;
#pragma unroll
        for (int i = 0; i < 12; ++i) { x[i] -= mean; q += x[i] * x[i]; }
        const float rs = 1.0f / sqrtf(wave_sum(q) * (1.0f / 768) + EPS);
#pragma unroll
        for (int i = 0; i < 12; ++i) { const int c = i * 64 + lane, g = c / 192; const float vn = x[i] * rs * lg[c] + lb[c];
            P.out[O_VNS + ((size_t)layer * DECB + b) * 768 + c] = vn;
            const float mix = P.w_spatial[((size_t)layer * 4 + g) * 128 * 128] * vn + P.b_spatial[(layer * 4 + g) * 128];
            SGS[b * 768 + c] = f2bf(z[OU + c] * mix * z[OGB + c]); }
    }
}

DI void g2_wave_tile(const Params& P, int layer, bool smp, int rt, int ct, int lane) {
    unsigned char* ws = P.ws;
    const bf16_t* AGp = smp ? (const bf16_t*)(ws + WS_SMP + SM_AGS) : (const bf16_t*)(ws + WS_AG);
    const bf16_t* SGp = smp ? (const bf16_t*)(ws + WS_SMP + SM_SGS) : (const bf16_t*)(ws + WS_SG);
    bf16_t* MGp = smp ? (bf16_t*)(ws + WS_SMP + SM_MGS) : (bf16_t*)(ws + WS_MG);
    f32x16 a = {}, b = {};
    a = wave_gemm32(AGp, 256, (const bf16_t*)(ws + WS_WPA) + (size_t)layer * DM * 256, 256, 256, rt * 32, ct * 32, lane, a);
    b = wave_gemm32(SGp, 768, (const bf16_t*)(ws + WS_WPB) + (size_t)layer * DM * 768, 768, 768, rt * 32, ct * 32, lane, b);
    const int hi = lane >> 5, col = ct * 32 + (lane & 31);
#pragma unroll
    for (int r = 0; r < 16; ++r) { const int row = rt * 32 + crow(r, hi); float ga, gb;
        if (smp) { const float* z = (const float*)(ws + WS_SMP + SM_ZSF) + (size_t)row * NIN + OGT; ga = z[col]; gb = z[DM + col]; }
        else { const bf16_t* z = (const bf16_t*)(ws + WS_ZB) + (size_t)row * NIN + OGT; ga = bf2f(z[col]); gb = bf2f(z[DM + col]); }
        MGp[(size_t)row * DM + col] = f2bf(ga * a[r] + gb * b[r]); }
}
DI void ph_g2_naive(const Params& P, int layer, int gw, int ngw, int lane) {
    constexpr int CT = DM / 32, RT = M / 32;
    for (int it = gw; it < RT * CT + CT; it += ngw) {
        if (it < RT * CT) g2_wave_tile(P, layer, false, it / CT, it % CT, lane); else g2_wave_tile(P, layer, true, 0, it - RT * CT, lane);
    }
}
DI void g3_wave_tile(const Params& P, int layer, bool smp, int rt, int ct, int lane) {
    unsigned char* ws = P.ws;
    const bf16_t* MGp = smp ? (const bf16_t*)(ws + WS_SMP + SM_MGS) : (const bf16_t*)(ws + WS_MG);
    float* Yp = smp ? (float*)(ws + WS_SMP + SM_YS) : (float*)(ws + WS_Y);
    f32x16 a = {};
    a = wave_gemm32(MGp, DM, (const bf16_t*)(ws + WS_WOUT) + (size_t)layer * DM * DM, DM, DM, rt * 32, ct * 32, lane, a);
    const int hi = lane >> 5, col = ct * 32 + (lane & 31);
#pragma unroll
    for (int r = 0; r < 16; ++r) Yp[(size_t)(rt * 32 + crow(r, hi)) * DM + col] = a[r];
}
DI void ph_g3_naive(const Params& P, int layer, int gw, int ngw, int lane) {
    constexpr int CT = DM / 32, RT = M / 32;
    for (int it = gw; it < RT * CT + CT; it += ngw) {
        if (it < RT * CT) g3_wave_tile(P, layer, false, it / CT, it % CT, lane); else g3_wave_tile(P, layer, true, 0, it - RT * CT, lane);
    }
}
DI void post_row(const float* xin, const float* y, const float* gpost, float* xout, bf16_t* xb, float* rstd_out, int lane) {
    const f32x4* yr = (const f32x4*)y + lane; const f32x4* xr = (const f32x4*)xin + lane; const f32x4* gr = (const f32x4*)gpost + lane;
    f32x4 v[4]; float ss = 0.f;
#pragma unroll
    for (int j = 0; j < 4; ++j) { v[j] = yr[64 * j]; ss += (v[j].x * v[j].x + v[j].y * v[j].y) + (v[j].z * v[j].z + v[j].w * v[j].w); }
    const float rs = 1.0f / sqrtf(wave_sum(ss) * (1.0f / DM) + EPS);
    float s2 = 0.f;
#pragma unroll
    for (int j = 0; j < 4; ++j) { const f32x4 x = xr[64 * j], g = gr[64 * j]; v[j] = x + v[j] * rs * g; s2 += (v[j].x * v[j].x + v[j].y * v[j].y) + (v[j].z * v[j].z + v[j].w * v[j].w); }
    s2 = wave_sum(s2);
    f32x4* xo = (f32x4*)xout + lane; unsigned long long* o8 = (unsigned long long*)xb + lane;
#pragma unroll
    for (int j = 0; j < 4; ++j) { xo[64 * j] = v[j]; o8[64 * j] = (unsigned long long)pk2(v[j].x, v[j].y) | ((unsigned long long)pk2(v[j].z, v[j].w) << 32); }
    if (lane == 0) *rstd_out = 1.0f / sqrtf(s2 * (1.0f / DM) + EPS);
}
DI void ph_post(const Params& P, int layer, int gw, int ngw, int lane) {
    unsigned char* ws = P.ws; const float* gpost = P.norm_post + layer * DM;
    for (int m = gw; m < M + DECB; m += ngw) {
        if (m < M) { const float* xin = (layer == 0) ? P.x_prompt + (size_t)m * DM : P.out + O_Y + (size_t)m * DM;
            post_row(xin, (const float*)(ws + WS_Y) + (size_t)m * DM, gpost, P.out + O_Y + (size_t)m * DM, (bf16_t*)(ws + WS_XB) + (size_t)m * DM, (float*)(ws + WS_RSTD) + m, lane); }
        else { const int b = m - M; const float* xin = (layer == 0) ? P.x_sample + (size_t)b * DM : P.out + O_YS + (size_t)b * DM;
            post_row(xin, (const float*)(ws + WS_SMP + SM_YS) + (size_t)b * DM, gpost, P.out + O_YS + (size_t)b * DM, (bf16_t*)(ws + WS_SMP + SM_XSB) + (size_t)b * DM, (float*)(ws + WS_SMP + SM_RSTD) + b, lane); }
    }
}

#define LAS __attribute__((address_space(3)))
#define XB_TMO      128
#define XB_XCNT(j)  (256  + 64 * (j))
#define XB_XSUB(j)  (1280 + 64 * (j))
#define XB_XGEN(j)  (2304 + 64 * (j))
#define XB_TOP      3328
#define XB_TOPGEN   3392
#define XCD_BAR_WORDS 3456
#define XB_SPIN_CAP (1u << 18)
__device__ __forceinline__ unsigned xb_ld(unsigned* p)              { return __hip_atomic_load(p, __ATOMIC_RELAXED, __HIP_MEMORY_SCOPE_AGENT); }
__device__ __forceinline__ unsigned xb_add(unsigned* p, unsigned v) { return __hip_atomic_fetch_add(p, v, __ATOMIC_RELAXED, __HIP_MEMORY_SCOPE_AGENT); }
__device__ __forceinline__ unsigned xb_xcc_id() { return (unsigned)__builtin_amdgcn_s_getreg((3 << 11) | 20) & 0xFu; }
#define XB_SPIN(cond, bar) do { unsigned _sp = 0; while (cond) { __builtin_amdgcn_s_sleep(1); \
    if ((++_sp & 255u) == 0u) { if (xb_ld(&(bar)[XB_TMO])) break; if (_sp > XB_SPIN_CAP) { atomicAdd(&(bar)[XB_TMO], 1u); break; } } } } while (0)
struct XcdBarrier { unsigned* bar; unsigned x; volatile LAS unsigned* st; };
__device__ __forceinline__ XcdBarrier xcd_barrier_post(unsigned* bar, volatile LAS unsigned* st) {
    XcdBarrier b; b.bar = bar; b.x = xb_xcc_id(); b.st = st;
    if (threadIdx.x == 0) (void)xb_add(&bar[XB_XCNT(b.x)], 1u);
    return b;
}
__device__ __forceinline__ void xcd_barrier_complete(unsigned* bar, unsigned x, unsigned& nloc, unsigned& nx) {
    const unsigned G = gridDim.x * gridDim.y * gridDim.z;
    unsigned sum, cnt, mine, sp = 0u;
    for (;;) {
        sum = 0u; cnt = 0u; mine = 0u;
#pragma unroll
        for (unsigned j = 0; j < 16; ++j) { const unsigned c = xb_ld(&bar[XB_XCNT(j)]); sum += c; cnt += (c > 0u) ? 1u : 0u; mine = (j == x) ? c : mine; }
        if (sum == G) break;
        __builtin_amdgcn_s_sleep(1);
        if ((++sp & 255u) == 0u) { if (xb_ld(&bar[XB_TMO])) break; if (sp > XB_SPIN_CAP) { atomicAdd(&bar[XB_TMO], 1u); break; } }
    }
    nloc = mine > 0u ? mine : 1u; nx = cnt > 0u ? cnt : 1u;
}
__device__ __forceinline__ void xcd_barrier(const XcdBarrier& b) {
    asm volatile("s_waitcnt vmcnt(0)" ::: "memory");
    __syncthreads();
    if (threadIdx.x == 0) {
        unsigned* bar = b.bar;
        __builtin_amdgcn_s_waitcnt(0);
        unsigned nloc = b.st[0], nx = b.st[1];
        if (nloc == 0u) { xcd_barrier_complete(bar, b.x, nloc, nx); b.st[0] = nloc; b.st[1] = nx; }
        const unsigned old = xb_add(&bar[XB_XSUB(b.x)], 1u);
        const unsigned gen = old / nloc;
        if (old + 1u == (gen + 1u) * nloc) {
            __builtin_amdgcn_fence(__ATOMIC_RELEASE, "agent");
            asm volatile("s_waitcnt vmcnt(0)" ::: "memory");
            const unsigned og = xb_add(&bar[XB_TOP], 1u);
            const unsigned tg = og / nx;
            if (og + 1u == (tg + 1u) * nx) xb_add(&bar[XB_TOPGEN], 1u);
            else XB_SPIN(xb_ld(&bar[XB_TOPGEN]) == tg, bar);
            __builtin_amdgcn_fence(__ATOMIC_ACQUIRE, "agent");
            xb_add(&bar[XB_XGEN(b.x)], 1u);
            asm volatile("s_waitcnt vmcnt(0)" ::: "memory");
        } else {
            XB_SPIN(xb_ld(&bar[XB_XGEN(b.x)]) == gen, bar);
            __builtin_amdgcn_fence(__ATOMIC_ACQUIRE, "agent");
            asm volatile("s_waitcnt vmcnt(0)" ::: "memory");
        }
    }
    __syncthreads();
}

constexpr int NT = 512;
constexpr int RING_BYTES = 131072, LDSCTL_OFF = RING_BYTES, MISC_OFF = LDSCTL_OFF + 320, LDS_BYTES = 147456;
constexpr int CW_BAR = 4096;
constexpr size_t CTL_ZERO_BYTES = 65536;
__global__ void __launch_bounds__(NT, 2) mega_kernel(Params P) {
    extern __shared__ __attribute__((aligned(16))) unsigned char lds[];
    const int tid = threadIdx.x, lane = tid & 63, wave = __builtin_amdgcn_readfirstlane(tid >> 6);
    const int G = gridDim.x;
    const int vcu = (G % 8 == 0) ? ((int)blockIdx.x % 8) * (G / 8) + (int)blockIdx.x / 8 : (int)blockIdx.x;
    const int gw = vcu * (NT / 64) + wave, ngw = G * (NT / 64);
    LAS unsigned char* l3 = (LAS unsigned char*)lds;
    for (int u = tid; u < (LDS_BYTES - LDSCTL_OFF) / 4; u += NT) ((LAS unsigned*)(l3 + LDSCTL_OFF))[u] = 0u;
    __syncthreads();
    volatile LAS unsigned* MISC = (volatile LAS unsigned*)(l3 + MISC_OFF);
    XcdBarrier bar = xcd_barrier_post((unsigned*)(P.ws + WS_CTL) + CW_BAR, MISC + 8);

    ph_prologue(P, (float*)lds, gw, ngw, wave, lane);
    xcd_barrier(bar);
#pragma unroll 1
    for (int L = 0; L < DEPTH; ++L) {
#define LAUNDER() int lane_ = lane, tid_ = tid, gw_ = gw; asm volatile("" : "+v"(lane_), "+v"(tid_), "+v"(gw_))
        { LAUNDER(); ph_g1_naive(P, L, gw_, ngw, lane_); }
        xcd_barrier(bar);
        { LAUNDER(); ph_gmlp_naive(P, L, vcu, G, tid_, NT); }
        { LAUNDER(); ph_attn_naive(P, L, gw_, ngw, lane_); }
        { LAUNDER(); ph_attn_sample(P, L, gw_, ngw, lane_); ph_gmlp_sample(P, L, ngw - 1 - gw_, ngw, lane_); }
        xcd_barrier(bar);
        { LAUNDER(); ph_g2_naive(P, L, gw_, ngw, lane_); }
        xcd_barrier(bar);
        { LAUNDER(); ph_g3_naive(P, L, gw_, ngw, lane_); }
        xcd_barrier(bar);
        { LAUNDER(); ph_post(P, L, gw_, ngw, lane_); }
        if (L + 1 < DEPTH) xcd_barrier(bar);
    }
}

extern "C" void kernel_launch(void* const* d_in, const int* in_sizes, int n_in, void* d_out, int out_size, void* d_ws, size_t ws_size, hipStream_t stream) {
    static int grid = 0;
    if (grid == 0) {
        if (n_in != 16 || (size_t)out_size != O_END || ws_size < WS_END) { fprintf(stderr, "kernel_launch: unexpected shapes n_in %d out %d ws %zu\n", n_in, out_size, ws_size); grid = -1; return; }
        int dev = 0, cus = 0, per_cu = 0;
        if (hipGetDevice(&dev) != hipSuccess || hipDeviceGetAttribute(&cus, hipDeviceAttributeMultiprocessorCount, dev) != hipSuccess) { grid = -1; return; }
        if (hipFuncSetAttribute((const void*)mega_kernel, hipFuncAttributeMaxDynamicSharedMemorySize, LDS_BYTES) != hipSuccess) { fprintf(stderr, "kernel_launch: hipFuncSetAttribute failed\n"); grid = -1; return; }
        if (hipOccupancyMaxActiveBlocksPerMultiprocessor(&per_cu, (const void*)mega_kernel, NT, LDS_BYTES) != hipSuccess || per_cu < 1) { fprintf(stderr, "kernel_launch: occupancy query says %d blocks per CU\n", per_cu); grid = -1; (void)hipGetLastError(); return; }
        grid = cus;
    }
    if (grid < 0) return;
    if (hipMemsetAsync((char*)d_ws + WS_CTL, 0, CTL_ZERO_BYTES, stream) != hipSuccess) return;
    Params P{};
    P.x_prompt = (const float*)d_in[0]; P.x_sample = (const float*)d_in[1]; P.cache[0] = (const float*)d_in[2]; P.cache[1] = (const float*)d_in[3]; P.cache[2] = (const float*)d_in[4];
    P.norm_pre = (const float*)d_in[5]; P.w_in = (const float*)d_in[6]; P.b_merge = (const float*)d_in[7]; P.v_norm_g = (const float*)d_in[8]; P.v_norm_b = (const float*)d_in[9];
    P.w_spatial = (const float*)d_in[10]; P.b_spatial = (const float*)d_in[11]; P.w_pa = (const float*)d_in[12]; P.w_pb = (const float*)d_in[13]; P.w_out = (const float*)d_in[14]; P.norm_post = (const float*)d_in[15];
    P.out = (float*)d_out; P.ws = (unsigned char*)d_ws;
    hipLaunchKernelGGL(mega_kernel, dim3(grid), dim3(NT), LDS_BYTES, stream, P);
}
```

```cpp
#include <hip/hip_runtime.h>
#include <stdint.h>
#include <cstdio>

typedef unsigned short bf16_t;
typedef short bf16x8 __attribute__((ext_vector_type(8)));
typedef float f32x16 __attribute__((ext_vector_type(16)));
typedef float f32x4 __attribute__((ext_vector_type(4)));
typedef unsigned u32x4 __attribute__((ext_vector_type(4)));
#define DI __device__ __forceinline__

constexpr int DM = 1024, BATCH = 8, SEQ = 2048, DEPTH = 4, DECB = 32, PAST = 8192;
constexpr int M = BATCH * SEQ;
constexpr int NIN = 6912;
constexpr int OQ = 0, OKK = 768, OV = 1536, OGA = 2304, OU = 2560, OGV = 3328, OGB = 4096, OGT = 4864;
constexpr float EPS = 1e-6f;
constexpr float C2 = 0.18033688011112042f;
constexpr size_t O_Y = 0, O_YS = 16777216, O_KV128P = 16809984, O_KV512P = 18907136, O_KV2048P = 27295744,
                 O_KV128S = 60850176, O_KV512S = 60915712, O_KV2048S = 60981248, O_VNS = 61046784, O_END = 61145088;
constexpr size_t MiB = 1u << 20;
constexpr size_t WS_CTL = 0, WS_ROPE = 1 * MiB, WS_WIN = 2 * MiB, WS_W2 = 56 * MiB  , WS_WOUT = 64 * MiB, WS_WSB = 72 * MiB,
                 WS_XB = 74 * MiB, WS_RSTD = 106 * MiB, WS_ZB = 108 * MiB, WS_ASG = 324 * MiB  , WS_MG = 356 * MiB, WS_Y = 388 * MiB,
                 WS_VN = 452 * MiB, WS_SMP = 480 * MiB, WS_END = 484 * MiB;
constexpr size_t SM_XSB = 0, SM_RSTD = 65536, SM_ZSF = 131072  , SM_AGS = 1048576, SM_SGS = 1048576 + 16384, SM_MGS = 1048576 + 65536,
                 SM_YS = 1048576 + 131072;

struct Params {
    const float* x_prompt; const float* x_sample; const float* cache[3];
    const float* norm_pre; const float* w_in; const float* b_merge; const float* v_norm_g; const float* v_norm_b;
    const float* w_spatial; const float* b_spatial; const float* w_pa; const float* w_pb; const float* w_out; const float* norm_post;
    float* out; unsigned char* ws;
    int phase; int layer;
};

DI float bf2f(bf16_t b) { return __uint_as_float((unsigned)b << 16); }
DI float bfs2f(short b) { return __uint_as_float(((unsigned)(unsigned short)b) << 16); }
DI bf16_t f2bf(float f) { unsigned u = __float_as_uint(f); return (bf16_t)((u + 0x7fffu + ((u >> 16) & 1u)) >> 16); }
DI unsigned pk2(float lo, float hi) { return (unsigned)f2bf(lo) | ((unsigned)f2bf(hi) << 16); }
DI float sigmoidf_(float x) { return 1.0f / (1.0f + __expf(-x)); }
DI float siluf_(float x) { return x * sigmoidf_(x); }
DI float geluf_(float x) { return x * sigmoidf_(1.5957691216057308f * (x + 0.044715f * x * x * x)); }
DI float wave_sum(float v) {
#pragma unroll
    for (int o = 1; o < 64; o <<= 1) v += __shfl_xor(v, o);
    return v;
}
DI float wave_max(float v) {
#pragma unroll
    for (int o = 1; o < 64; o <<= 1) v = fmaxf(v, __shfl_xor(v, o));
    return v;
}
DI int crow(int r, int hi) { return (r & 3) + 8 * (r >> 2) + 4 * hi; }

DI void sincos_d(double a, double& s, double& c) {
    const double TWO_PI = 6.283185307179586476925286766559;
    double n = rint(a / TWO_PI);
    double r = a - n * TWO_PI;
    double x = r * 0.125, x2 = x * x;
    double sv = x * (1.0 + x2 * (-1.0 / 6 + x2 * (1.0 / 120 + x2 * (-1.0 / 5040 + x2 * (1.0 / 362880 + x2 * (-1.0 / 39916800 + x2 * (1.0 / 6227020800.0)))))));
    double cv = 1.0 + x2 * (-0.5 + x2 * (1.0 / 24 + x2 * (-1.0 / 720 + x2 * (1.0 / 40320 + x2 * (-1.0 / 3628800 + x2 * (1.0 / 479001600.0 + x2 * (-1.0 / 87178291200.0)))))));
#pragma unroll
    for (int i = 0; i < 3; ++i) { double s2 = 2.0 * sv * cv, c2 = 1.0 - 2.0 * sv * sv; sv = s2; cv = c2; }
    s = sv; c = cv;
}

DI void transpose_item(const float* W, int K, int N, bf16_t* WT, int ldw, const float* kscale, float* scr, int item, int lane) {
    const int nblk = N / 32, kb = item / nblk, nb = item % nblk, k0 = 64 * kb, n0 = 32 * nb;
#pragma unroll 8
    for (int i = 0; i < 32; ++i) { const int kk = 2 * i + (lane >> 5); float v = W[(size_t)(k0 + kk) * N + n0 + (lane & 31)]; if (kscale) v *= kscale[k0 + kk]; scr[kk * 33 + (lane & 31)] = v; }
    __builtin_amdgcn_s_waitcnt(0xc07f); asm volatile("" ::: "memory");
    const int c = lane & 7;
#pragma unroll
    for (int j = 0; j < 4; ++j) { const int n = (lane >> 3) + 8 * j; const float* s = scr + (8 * c) * 33 + n;
        u32x4 o; o.x = pk2(s[0 * 33], s[1 * 33]); o.y = pk2(s[2 * 33], s[3 * 33]); o.z = pk2(s[4 * 33], s[5 * 33]); o.w = pk2(s[6 * 33], s[7 * 33]);
        *(u32x4*)(WT + (size_t)(n0 + n) * ldw + k0 + 8 * c) = o; }
    __builtin_amdgcn_s_waitcnt(0xc07f); asm volatile("" ::: "memory");
}
DI void row_to_bf16(const float* xrow, bf16_t* orow, float* rstd_out, int lane) {
    const f32x4* xr = (const f32x4*)xrow + lane; f32x4 v[4]; float ss = 0.f;
#pragma unroll
    for (int j = 0; j < 4; ++j) { v[j] = xr[64 * j]; ss += (v[j].x * v[j].x + v[j].y * v[j].y) + (v[j].z * v[j].z + v[j].w * v[j].w); }
    ss = wave_sum(ss);
    unsigned long long* o8 = (unsigned long long*)orow + lane;
#pragma unroll
    for (int j = 0; j < 4; ++j) o8[64 * j] = (unsigned long long)pk2(v[j].x, v[j].y) | ((unsigned long long)pk2(v[j].z, v[j].w) << 32);
    if (lane == 0) *rstd_out = 1.0f / sqrtf(ss * (1.0f / DM) + EPS);
}
DI void ph_prologue(const Params& P, float* lds_f, int gw, int ngw, int wave, int lane) {
    unsigned char* ws = P.ws;
    float* scr = lds_f + wave * (64 * 33);
    constexpr int I_IN = (DM / 64) * (NIN / 32), I_PA = (256 / 64) * (DM / 32), I_PB = (768 / 64) * (DM / 32), I_OUT = (DM / 64) * (DM / 32), I_L = I_IN + I_PA + I_PB + I_OUT;
    for (int it = gw; it < DEPTH * I_L; it += ngw) {
        const int l = it / I_L; int r = it % I_L;
        if (r < I_IN) { transpose_item(P.w_in + (size_t)l * DM * NIN, DM, NIN, (bf16_t*)(ws + WS_WIN) + (size_t)l * NIN * DM, DM, P.norm_pre + l * DM, scr, r, lane); continue; } r -= I_IN;
        if (r < I_PA) { transpose_item(P.w_pa + (size_t)l * 256 * DM, 256, DM, (bf16_t*)(ws + WS_W2) + (size_t)l * DM * DM, DM, nullptr, scr, r, lane); continue; } r -= I_PA;
        if (r < I_PB) { transpose_item(P.w_pb + (size_t)l * 768 * DM, 768, DM, (bf16_t*)(ws + WS_W2) + (size_t)l * DM * DM + 256, DM, nullptr, scr, r, lane); continue; } r -= I_PB;
        transpose_item(P.w_out + (size_t)l * DM * DM, DM, DM, (bf16_t*)(ws + WS_WOUT) + (size_t)l * DM * DM, DM, nullptr, scr, r, lane);
    }
    { bf16_t* wsb = (bf16_t*)(ws + WS_WSB);
      for (int e = gw * 64 + lane; e < DEPTH * 4 * 128 * 128; e += ngw * 64) { const int j = e & 127, i = (e >> 7) & 127; wsb[e] = (j <= i) ? f2bf(P.w_spatial[e]) : (bf16_t)0; } }
    { float* rc = (float*)(ws + WS_ROPE); float* rs = rc + 2049 * 8;
      for (int e = gw * 64 + lane; e < 2049 * 8; e += ngw * 64) { const int pi = e >> 3, i = e & 7; const float pos = (pi == 2048) ? (float)PAST : (float)pi;
          float fr = 1.0f;
          fr = (i == 1) ? 0.1939227432012558f : fr; fr = (i == 2) ? 0.03760603070259094f : fr; fr = (i == 3) ? 0.007292664609849453f : fr; fr = (i == 4) ? 0.0014142135623842478f : fr;
          fr = (i == 5) ? 0.00027424818836152554f : fr; fr = (i == 6) ? 5.318296098266728e-05f : fr; fr = (i == 7) ? 1.0313386155758053e-05f : fr;
          const float ang = pos * fr; double s, c; sincos_d((double)ang, s, c); rc[e] = (float)c; rs[e] = (float)s; } }
    for (int m = gw; m < M + DECB; m += ngw) {
        if (m < M) row_to_bf16(P.x_prompt + (size_t)m * DM, (bf16_t*)(ws + WS_XB) + (size_t)m * DM, (float*)(ws + WS_RSTD) + m, lane);
        else { const int b = m - M; row_to_bf16(P.x_sample + (size_t)b * DM, (bf16_t*)(ws + WS_SMP + SM_XSB) + (size_t)b * DM, (float*)(ws + WS_SMP + SM_RSTD) + b, lane); }
    }
}

DI f32x16 wave_gemm32(const bf16_t* A, int lda, const bf16_t* Bt, int ldb, int K, int row0, int col0, int lane, f32x16 acc) {
    const int r = lane & 31, h = lane >> 5;
    const bf16_t* ap = A + (size_t)(row0 + r) * lda + 8 * h;
    const bf16_t* bp = Bt + (size_t)(col0 + r) * ldb + 8 * h;
#pragma unroll 4
    for (int k0 = 0; k0 < K; k0 += 16) {
        const bf16x8 a = *(const bf16x8*)(ap + k0), b = *(const bf16x8*)(bp + k0);
        acc = __builtin_amdgcn_mfma_f32_32x32x16_bf16(a, b, acc, 0, 0, 0);
    }
    return acc;
}

DI void g1_epi_scalar(const Params& P, int layer, bool smp, int row, int col, float v, float pv) {
    unsigned char* ws = P.ws;
    float val = v;
    if (col < OV) {
        const int dd = col & 63;
        if (dd < 16) { const int t = smp ? 2048 : (row & (SEQ - 1)); const float* rc = (const float*)(ws + WS_ROPE); const float c = rc[t * 8 + (dd & 7)], s = rc[2049 * 8 + t * 8 + (dd & 7)];
            val = (dd < 8) ? (v * c - pv * s) : (v * c + pv * s); }
        if (col < OKK) val *= C2;
    } else if (col < OGA) {
    } else if (col < OU) val = siluf_(v);
    else if (col < OGB) val = geluf_(v);
    else if (col < OGT) val = siluf_(v);
    else val = sigmoidf_(v + P.b_merge[layer * 2 * DM + (col - OGT)]);
    if (smp) ((float*)(ws + WS_SMP + SM_ZSF))[(size_t)row * NIN + col] = val;
    else ((bf16_t*)(ws + WS_ZB))[(size_t)row * NIN + col] = f2bf(val);
    if (col >= OKK && col < OGA) {
        const int kv = (col >= OV) ? 1 : 0, hh = (col - (kv ? OV : OKK)) >> 6, g = hh >> 2, hs = hh & 3, dd = col & 63;
        if (smp) { const size_t base = (g == 0) ? O_KV128S : (g == 1) ? O_KV512S : O_KV2048S;
            P.out[base + ((size_t)layer * DECB + row) * 512 + kv * 256 + hs * 64 + dd] = val; }
        else { const int keep = 128 << (2 * g), b = row >> 11, t = row & (SEQ - 1), j = t - (SEQ - keep);
            if (j >= 0) { const size_t base = (g == 0) ? O_KV128P : (g == 1) ? O_KV512P : O_KV2048P;
                P.out[base + (((size_t)layer * BATCH + b) * keep + j) * 512 + kv * 256 + hs * 64 + dd] = val; } }
    }
}
DI void g1_wave_tile(const Params& P, int layer, bool smp, int rt, int ct, int lane) {
    unsigned char* ws = P.ws;
    const bf16_t* A = smp ? (const bf16_t*)(ws + WS_SMP + SM_XSB) : (const bf16_t*)(ws + WS_XB);
    const float* rstd = smp ? (const float*)(ws + WS_SMP + SM_RSTD) : (const float*)(ws + WS_RSTD);
    const bf16_t* Bt = (const bf16_t*)(ws + WS_WIN) + (size_t)layer * NIN * DM;
    f32x16 acc = {};
    acc = wave_gemm32(A, DM, Bt, DM, DM, rt * 32, ct * 32, lane, acc);
    const int hi = lane >> 5, col = ct * 32 + (lane & 31);
#pragma unroll
    for (int r = 0; r < 16; ++r) { const int row = rt * 32 + crow(r, hi); const float v = acc[r] * rstd[row]; const float pv = __shfl_xor(v, 8); g1_epi_scalar(P, layer, smp, row, col, v, pv); }
}
DI void ph_g1_naive(const Params& P, int layer, int gw, int ngw, int lane) {
    constexpr int CT = NIN / 32, RT = M / 32;
    for (int it = gw; it < RT * CT + CT; it += ngw) {
        if (it < RT * CT) { const int rt = it / CT, ct = it % CT; g1_wave_tile(P, layer, false, rt, ct, lane); }
        else g1_wave_tile(P, layer, true, 0, it - RT * CT, lane);
    }
}

DI void ph_attn_naive(const Params& P, int layer, int gw, int ngw, int lane) {
    unsigned char* ws = P.ws; const bf16_t* ZB = (const bf16_t*)(ws + WS_ZB); bf16_t* ASG = (bf16_t*)(ws + WS_ASG);
    for (int item = gw; item < M * 4; item += ngw) {
        const int row = item >> 2, hs = item & 3, t = row & (SEQ - 1), b0 = row - t;
        float m = -INFINITY, l = 0.f, o = 0.f;
        for (int g = 0; g < 3; ++g) {
            const int d = 1 << (2 * g), head = g * 4 + hs;
            const bf16_t* qp = ZB + (size_t)row * NIN + OQ + head * 64;
            bf16x8 qv[8];
#pragma unroll
            for (int i = 0; i < 8; ++i) qv[i] = *(const bf16x8*)(qp + 8 * i);
            for (int jb = 0; jb < 3; ++jb) {
                const int j = jb * 64 + lane, p = t - d * j; const bool valid = (j <= 128) && (p >= 0);
                float s = -INFINITY;
                if (valid) { const bf16_t* kp = ZB + (size_t)(b0 + p) * NIN + OKK + head * 64; float acc = 0.f;
#pragma unroll
                    for (int i = 0; i < 8; ++i) { const bf16x8 kv = *(const bf16x8*)(kp + 8 * i);
#pragma unroll
                        for (int e = 0; e < 8; ++e) acc += bfs2f(qv[i][e]) * bfs2f(kv[e]); }
                    s = acc; }
                const float mx = wave_max(s);
                if (mx == -INFINITY) continue;
                const float mn = fmaxf(m, mx), sc = exp2f(m - mn), pj = valid ? exp2f(s - mn) : 0.f;
                l = l * sc + wave_sum(pj); o *= sc; m = mn;
                const int nj = (129 - jb * 64) < 64 ? (129 - jb * 64) : 64;
                for (int jj = 0; jj < nj; ++jj) { const int pp = t - d * (jb * 64 + jj); if (pp < 0) break;
                    const float pjj = __shfl(pj, jj); o += pjj * bf2f(ZB[(size_t)(b0 + pp) * NIN + OV + head * 64 + lane]); }
            }
        }
        const float gate = bf2f(ZB[(size_t)row * NIN + OGA + hs * 64 + lane]);
        ASG[(size_t)row * DM + hs * 64 + lane] = f2bf(o / l * gate);
    }
}
DI void ph_attn_sample(const Params& P, int layer, int gw, int ngw, int lane) {
    unsigned char* ws = P.ws; const float* ZSF = (const float*)(ws + WS_SMP + SM_ZSF); bf16_t* AGS = (bf16_t*)(ws + WS_SMP + SM_AGS);
    for (int item = gw; item < DECB * 4; item += ngw) {
        const int b = item >> 2, hs = item & 3;
        float m = -INFINITY, l = 0.f, o = 0.f;
        for (int g = 0; g < 3; ++g) {
            const int d = 1 << (2 * g), W = 128 << (2 * g), head = g * 4 + hs;
            const float* cache = P.cache[g] + ((size_t)layer * DECB + b) * W * 512;
            const float* qp = ZSF + (size_t)b * NIN + OQ + head * 64;
            const float* kself = ZSF + (size_t)b * NIN + OKK + head * 64; const float* vself = ZSF + (size_t)b * NIN + OV + head * 64;
            for (int jb = 0; jb < 3; ++jb) {
                const int j = jb * 64 + lane; const bool valid = (j <= 128);
                float s = -INFINITY;
                if (valid) { const float* kp = (j == 0) ? kself : cache + (size_t)(W - d * j) * 512 + hs * 64; float acc = 0.f;
#pragma unroll 8
                    for (int i = 0; i < 64; i += 4) { const f32x4 kk = *(const f32x4*)(kp + i), qq = *(const f32x4*)(qp + i); acc += (kk.x * qq.x + kk.y * qq.y) + (kk.z * qq.z + kk.w * qq.w); }
                    s = acc; }
                const float mx = wave_max(s);
                const float mn = fmaxf(m, mx), sc = exp2f(m - mn), pj = valid ? exp2f(s - mn) : 0.f;
                l = l * sc + wave_sum(pj); o *= sc; m = mn;
                const int nj = (129 - jb * 64) < 64 ? (129 - jb * 64) : 64;
                for (int jj = 0; jj < nj; ++jj) { const int jg = jb * 64 + jj; const float* vp = (jg == 0) ? vself : cache + (size_t)(W - d * jg) * 512 + 256 + hs * 64;
                    o += __shfl(pj, jj) * vp[lane]; }
            }
        }
        const float gate = ZSF[(size_t)b * NIN + OGA + hs * 64 + lane];
        AGS[b * 256 + hs * 64 + lane] = f2bf(o / l * gate);
    }
}

DI void ph_gmlp_naive(const Params& P, int layer, int wg, int nwg, int tid, int nthreads) {
    unsigned char* ws = P.ws; const bf16_t* ZB = (const bf16_t*)(ws + WS_ZB); bf16_t* VN = (bf16_t*)(ws + WS_VN); bf16_t* ASG = (bf16_t*)(ws + WS_ASG);
    const bf16_t* WSB = (const bf16_t*)(ws + WS_WSB) + (size_t)layer * 4 * 128 * 128;
    const float* lg = P.v_norm_g + layer * 768; const float* lb = P.v_norm_b + layer * 768; const float* bsp = P.b_spatial + layer * 4 * 128;
    const int wave = tid >> 6, lane = tid & 63, nwaves = nthreads >> 6;
    for (int ch = wg; ch < M / 128; ch += nwg) {
        const int r0 = ch * 128;
        for (int r = wave; r < 128; r += nwaves) {
            const bf16_t* gp = ZB + (size_t)(r0 + r) * NIN + OGV; float x[12]; float s = 0.f;
#pragma unroll
            for (int i = 0; i < 12; ++i) { x[i] = bf2f(gp[i * 64 + lane]); s += x[i]; }
            const float mean = wave_sum(s) * (1.0f / 768); float q = 0.f;
#pragma unroll
            for (int i = 0; i < 12; ++i) { x[i] -= mean; q += x[i] * x[i]; }
            const float rs = 1.0f / sqrtf(wave_sum(q) * (1.0f / 768) + EPS);
#pragma unroll
            for (int i = 0; i < 12; ++i) { const int c = i * 64 + lane; VN[(size_t)(r0 + r) * 768 + c] = f2bf(x[i] * rs * lg[c] + lb[c]); }
        }
        __threadfence_block();
        __syncthreads();
        for (int e = tid; e < 128 * 768; e += nthreads) {
            const int i = e / 768, c = e % 768, g = c / 192; const bf16_t* wrow = WSB + (g * 128 + i) * 128; float acc = 0.f;
            for (int j = 0; j <= i; ++j) acc += bf2f(wrow[j]) * bf2f(VN[(size_t)(r0 + j) * 768 + c]);
            const float mix = acc + bsp[g * 128 + i];
            const size_t zr = (size_t)(r0 + i) * NIN;
            ASG[(size_t)(r0 + i) * DM + 256 + c] = f2bf(bf2f(ZB[zr + OU + c]) * mix * bf2f(ZB[zr + OGB + c]));
        }
        __syncthreads();
    }
}
DI void ph_gmlp_sample(const Params& P, int layer, int gw, int ngw, int lane) {
    unsigned char* ws = P.ws; const float* ZSF = (const float*)(ws + WS_SMP + SM_ZSF); bf16_t* SGS = (bf16_t*)(ws + WS_SMP + SM_SGS);
    const float* lg = P.v_norm_g + layer * 768; const float* lb = P.v_norm_b + layer * 768;
    for (int b = gw; b < DECB; b += ngw) {
        const float* z = ZSF + (size_t)b * NIN; float x[12]; float s = 0.f;
#pragma unroll
        for (int i = 0; i < 12; ++i) { x[i] = z[OGV + i * 64 + lane]; s += x[i]; }
        const float mean = wave_sum(s) * (1.0f / 768); float q = 0.f;
#pragma unroll
        for (int i = 0; i < 12; ++i) { x[i] -= mean; q += x[i] * x[i]; }
        const float rs = 1.0f / sqrtf(wave_sum(q) * (1.0f / 768) + EPS);
#pragma unroll
        for (int i = 0; i < 12; ++i) { const int c = i * 64 + lane, g = c / 192; const float vn = x[i] * rs * lg[c] + lb[c];
            P.out[O_VNS + ((size_t)layer * DECB + b) * 768 + c] = vn;
            const float mix = P.w_spatial[((size_t)layer * 4 + g) * 128 * 128] * vn + P.b_spatial[(layer * 4 + g) * 128];
            SGS[b * 768 + c] = f2bf(z[OU + c] * mix * z[OGB + c]); }
    }
}

DI void g2_wave_tile(const Params& P, int layer, bool smp, int rt, int ct, int lane) {
    unsigned char* ws = P.ws;
    const bf16_t* AGp = smp ? (const bf16_t*)(ws + WS_SMP + SM_AGS) : (const bf16_t*)(ws + WS_ASG);
    const bf16_t* SGp = smp ? (const bf16_t*)(ws + WS_SMP + SM_SGS) : (const bf16_t*)(ws + WS_ASG) + 256;
    bf16_t* MGp = smp ? (bf16_t*)(ws + WS_SMP + SM_MGS) : (bf16_t*)(ws + WS_MG);
    const bf16_t* W2 = (const bf16_t*)(ws + WS_W2) + (size_t)layer * DM * DM;
    f32x16 a = {}, b = {};
    a = wave_gemm32(AGp, smp ? 256 : DM, W2, DM, 256, rt * 32, ct * 32, lane, a);
    b = wave_gemm32(SGp, smp ? 768 : DM, W2 + 256, DM, 768, rt * 32, ct * 32, lane, b);
    const int hi = lane >> 5, col = ct * 32 + (lane & 31);
#pragma unroll
    for (int r = 0; r < 16; ++r) { const int row = rt * 32 + crow(r, hi); float ga, gb;
        if (smp) { const float* z = (const float*)(ws + WS_SMP + SM_ZSF) + (size_t)row * NIN + OGT; ga = z[col]; gb = z[DM + col]; }
        else { const bf16_t* z = (const bf16_t*)(ws + WS_ZB) + (size_t)row * NIN + OGT; ga = bf2f(z[col]); gb = bf2f(z[DM + col]); }
        MGp[(size_t)row * DM + col] = f2bf(ga * a[r] + gb * b[r]); }
}
DI void ph_g2_naive(const Params& P, int layer, int gw, int ngw, int lane) {
    constexpr int CT = DM / 32, RT = M / 32;
    for (int it = gw; it < RT * CT + CT; it += ngw) {
        if (it < RT * CT) g2_wave_tile(P, layer, false, it / CT, it % CT, lane); else g2_wave_tile(P, layer, true, 0, it - RT * CT, lane);
    }
}
DI void g3_wave_tile(const Params& P, int layer, bool smp, int rt, int ct, int lane) {
    unsigned char* ws = P.ws;
    const bf16_t* MGp = smp ? (const bf16_t*)(ws + WS_SMP + SM_MGS) : (const bf16_t*)(ws + WS_MG);
    float* Yp = smp ? (float*)(ws + WS_SMP + SM_YS) : (float*)(ws + WS_Y);
    f32x16 a = {};
    a = wave_gemm32(MGp, DM, (const bf16_t*)(ws + WS_WOUT) + (size_t)layer * DM * DM, DM, DM, rt * 32, ct * 32, lane, a);
    const int hi = lane >> 5, col = ct * 32 + (lane & 31);
#pragma unroll
    for (int r = 0; r < 16; ++r) Yp[(size_t)(rt * 32 + crow(r, hi)) * DM + col] = a[r];
}
DI void ph_g3_naive(const Params& P, int layer, int gw, int ngw, int lane) {
    constexpr int CT = DM / 32, RT = M / 32;
    for (int it = gw; it < RT * CT + CT; it += ngw) {
        if (it < RT * CT) g3_wave_tile(P, layer, false, it / CT, it % CT, lane); else g3_wave_tile(P, layer, true, 0, it - RT * CT, lane);
    }
}
DI void post_row(const float* xin, const float* y, const float* gpost, float* xout, bf16_t* xb, float* rstd_out, int lane) {
    const f32x4* yr = (const f32x4*)y + lane; const f32x4* xr = (const f32x4*)xin + lane; const f32x4* gr = (const f32x4*)gpost + lane;
    f32x4 v[4]; float ss = 0.f;
#pragma unroll
    for (int j = 0; j < 4; ++j) { v[j] = yr[64 * j]; ss += (v[j].x * v[j].x + v[j].y * v[j].y) + (v[j].z * v[j].z + v[j].w * v[j].w); }
    const float rs = 1.0f / sqrtf(wave_sum(ss) * (1.0f / DM) + EPS);
    float s2 = 0.f;
#pragma unroll
    for (int j = 0; j < 4; ++j) { const f32x4 x = xr[64 * j], g = gr[64 * j]; v[j] = x + v[j] * rs * g; s2 += (v[j].x * v[j].x + v[j].y * v[j].y) + (v[j].z * v[j].z + v[j].w * v[j].w); }
    s2 = wave_sum(s2);
    f32x4* xo = (f32x4*)xout + lane; unsigned long long* o8 = (unsigned long long*)xb + lane;
#pragma unroll
    for (int j = 0; j < 4; ++j) { xo[64 * j] = v[j]; o8[64 * j] = (unsigned long long)pk2(v[j].x, v[j].y) | ((unsigned long long)pk2(v[j].z, v[j].w) << 32); }
    if (lane == 0) *rstd_out = 1.0f / sqrtf(s2 * (1.0f / DM) + EPS);
}
DI void ph_post(const Params& P, int layer, int gw, int ngw, int lane) {
    unsigned char* ws = P.ws; const float* gpost = P.norm_post + layer * DM;
    for (int m = gw; m < M + DECB; m += ngw) {
        if (m < M) { const float* xin = (layer == 0) ? P.x_prompt + (size_t)m * DM : P.out + O_Y + (size_t)m * DM;
            post_row(xin, (const float*)(ws + WS_Y) + (size_t)m * DM, gpost, P.out + O_Y + (size_t)m * DM, (bf16_t*)(ws + WS_XB) + (size_t)m * DM, (float*)(ws + WS_RSTD) + m, lane); }
        else { const int b = m - M; const float* xin = (layer == 0) ? P.x_sample + (size_t)b * DM : P.out + O_YS + (size_t)b * DM;
            post_row(xin, (const float*)(ws + WS_SMP + SM_YS) + (size_t)b * DM, gpost, P.out + O_YS + (size_t)b * DM, (bf16_t*)(ws + WS_SMP + SM_XSB) + (size_t)b * DM, (float*)(ws + WS_SMP + SM_RSTD) + b, lane); }
    }
}

namespace pg8 {
#define PG8_LAS __attribute__((address_space(3)))
typedef unsigned short bf16_t;
typedef short bf16x8 __attribute__((ext_vector_type(8)));
typedef float f32x4 __attribute__((ext_vector_type(4)));
typedef unsigned u32x4 __attribute__((ext_vector_type(4)));
constexpr int BM = 256, BK = 64, HALF = 128, HTB = HALF * BK * 2  , STAGE_BYTES = 8 * HTB, NXCD = 8, WGM = 8;

__host__ __device__ __forceinline__ int lds_byte(int r, int c) { const int st = (r >> 4) * 2 + (c >> 5), rr = r & 15, cc = c & 31, ob = rr * 64 + cc * 2; return st * 1024 + (ob ^ (((ob >> 9) & 1) << 5)); }
__host__ __device__ __forceinline__ void stage_rc(int b, int& R, int& C) { const int st = b / 1024, sb = b % 1024, swz = sb ^ (((sb >> 9) & 1) << 5); R = (st >> 1) * 16 + swz / 64; C = (st & 1) * 32 + (swz % 64) / 2; }
__host__ __device__ __forceinline__ int perm32(int rho) { const int n = rho >> 4, i = rho & 15; return 8 * (i >> 2) + 4 * n + (i & 3); }

struct Unit { int pm, pn; };
struct Gemm { const bf16_t* A; const bf16_t* Bt; int M, N, K; };

struct StaticOrder {
    int nM, nN, nwg, G, c;
    __host__ __device__ void init(int M, int N, int G_, int c_) { nM = M / BM; nN = N / BM; nwg = nM * nN; G = G_; c = c_; }
    __host__ __device__ bool next(int i, Unit& u) const {
        const long L = (long)i * G + c; if (L >= nwg) return false;
        int wgid = (int)L; { const int q = nwg / NXCD, r = nwg % NXCD, xcd = wgid % NXCD, off = wgid / NXCD; wgid = (xcd < r ? xcd * (q + 1) : r * (q + 1) + (xcd - r) * q) + off; }
        const int nig = WGM * nN, gid = wgid / nig, fm = gid * WGM, gsz = (nM - fm) < WGM ? (nM - fm) : WGM;
        u.pm = fm + ((wgid % nig) % gsz); u.pn = (wgid % nig) / gsz; return true;
    }
    __device__ __forceinline__ void a_ready(const Unit&) const {}
    __device__ __forceinline__ void done(const Unit&) const {}
};

__device__ __forceinline__ unsigned cvt_pk_bf16(float lo, float hi) { unsigned r; asm volatile("v_cvt_pk_bf16_f32 %0, %1, %2" : "=v"(r) : "v"(lo), "v"(hi)); return r; }
typedef float f32x2 __attribute__((ext_vector_type(2)));
template <class Epi, class Sched, bool ALIGN_EPI = false, bool SP2 = false>
__device__ __forceinline__ void gemm_phase(PG8_LAS unsigned char* lds, const Gemm g, const Sched& S, const Epi& E) {
    int tid = threadIdx.x; asm volatile("" : "+v"(tid));
    const int wid = __builtin_amdgcn_readfirstlane(tid >> 6), lane = tid & 63, wr = wid >> 2, wc = wid & 3, fr = lane & 15, fq = lane >> 4;
    const int K = g.K, nt = K / BK;
    unsigned voffA[2], voffB[2];
#pragma unroll
    for (int i = 0; i < 2; ++i) { int R, C; stage_rc(tid * 16 + i * 8192, R, C); const int Rb = Epi::PERM ? ((R & ~31) + perm32(R & 31)) : R;
        voffA[i] = (unsigned)(R * K + C) * 2u; voffB[i] = (unsigned)(Rb * K + C) * 2u; }
    const size_t kstep = (size_t)(BK * 2);
    const size_t hstep = (size_t)HALF * K * 2;
    const size_t tstep = 2 * hstep;
    const unsigned ldsw = (unsigned)wid * 1024u;
    const int aoff = lds_byte(wr * 64 + fr, fq * 8), boff = lds_byte(wc * 32 + fr, fq * 8);
#define PG8_SA(b, h) (((b) * 2 + (h)) * HTB)
#define PG8_SB(b, h) ((4 + (b) * 2 + (h)) * HTB)
#define PG8_STAGE(bufoff, gbase, voff) do { _Pragma("unroll") for (int _i = 0; _i < 2; ++_i) \
        __builtin_amdgcn_global_load_lds((const unsigned*)((const char*)(gbase) + (voff)[_i]), (PG8_LAS unsigned*)(lds + (bufoff) + ldsw + _i * 8192), 16, 0, 0); } while (0)
#define PG8_LDA(dst, b, h) do { _Pragma("unroll") for (int m = 0; m < 4; ++m) _Pragma("unroll") for (int k = 0; k < 2; ++k) dst[m][k] = *(const PG8_LAS bf16x8*)(lds + PG8_SA(b, h) + aoff + m * 2048 + k * 1024); } while (0)
#define PG8_LDB(dst, b, h) do { _Pragma("unroll") for (int n = 0; n < 2; ++n) _Pragma("unroll") for (int k = 0; k < 2; ++k) dst[n][k] = *(const PG8_LAS bf16x8*)(lds + PG8_SB(b, h) + boff + n * 2048 + k * 1024); } while (0)
#define PG8_MMA(ai, bj, At, Bt) do { __builtin_amdgcn_s_setprio(1); _Pragma("unroll") for (int m = 0; m < 4; ++m) _Pragma("unroll") for (int n = 0; n < 2; ++n) _Pragma("unroll") for (int k = 0; k < 2; ++k) \
        acc[ai][bj][m][n] = __builtin_amdgcn_mfma_f32_16x16x32_bf16(Bt[n][k], At[m][k], acc[ai][bj][m][n], 0, 0, 0); __builtin_amdgcn_s_setprio(0); } while (0)
#define PG8_WAIT_V(n) asm volatile("s_waitcnt vmcnt(" #n ")" ::: "memory")
#define PG8_WAIT_L(n) asm volatile("s_waitcnt lgkmcnt(" #n ")" ::: "memory")
#define PG8_BAR __builtin_amdgcn_s_barrier()
#define PG8_SCHED __builtin_amdgcn_sched_barrier(0)
    Unit cur, nxt; int ui = 0;
    if (!S.next(0, cur)) return;
    f32x4 acc[2][2][4][2];
#pragma unroll
    for (int a = 0; a < 2; ++a)
#pragma unroll
        for (int b = 0; b < 2; ++b)
#pragma unroll
            for (int m = 0; m < 4; ++m)
#pragma unroll
                for (int n = 0; n < 2; ++n) acc[a][b][m][n] = (f32x4){0.f, 0.f, 0.f, 0.f};
    bf16x8 At[4][2], B0[2][2], B1[2][2];
    const char* cA = (const char*)g.A + (size_t)cur.pm * tstep; const char* cB = (const char*)g.Bt + (size_t)cur.pn * tstep;
    S.a_ready(cur);
    if constexpr (SP2) {
        PG8_STAGE(PG8_SB(0, 0), cB, voffB); PG8_STAGE(PG8_SB(0, 1), cB + hstep, voffB); PG8_STAGE(PG8_SA(0, 0), cA, voffA); PG8_STAGE(PG8_SA(0, 1), cA + hstep, voffA);
        if (wr == 1) PG8_BAR;
        PG8_WAIT_V(2); PG8_BAR;
        PG8_STAGE(PG8_SB(1, 0), cB + kstep, voffB); PG8_STAGE(PG8_SA(1, 0), cA + kstep, voffA); PG8_STAGE(PG8_SB(1, 1), cB + hstep + kstep, voffB);
        PG8_WAIT_V(6); PG8_BAR;
    } else {
        PG8_STAGE(PG8_SB(0, 0), cB, voffB); PG8_STAGE(PG8_SA(0, 0), cA, voffA); PG8_STAGE(PG8_SB(0, 1), cB + hstep, voffB); PG8_STAGE(PG8_SA(0, 1), cA + hstep, voffA);
        if (wr == 1) PG8_BAR;
        PG8_WAIT_V(4); PG8_BAR;
        PG8_STAGE(PG8_SB(1, 0), cB + kstep, voffB); PG8_STAGE(PG8_SA(1, 0), cA + kstep, voffA); PG8_STAGE(PG8_SB(1, 1), cB + hstep + kstep, voffB);
        PG8_WAIT_V(6); PG8_BAR;
    }
    for (;;) {
        const bool has_next = S.next(ui + 1, nxt);
        const char* nA = has_next ? (const char*)g.A + (size_t)nxt.pm * tstep : cA; const char* nB = has_next ? (const char*)g.Bt + (size_t)nxt.pn * tstep : cB;
        for (int t = 0; t < nt; t += 2) {
            if constexpr (Epi::HAS_MID) { if (t == Epi::MID_T) E.mid(acc, cur, wr, wc, fr, fq); }
            const bool last = (t == nt - 2);
            const char* a1 = cA + (size_t)(t + 1) * kstep;
            const char* a2 = last ? nA : cA + (size_t)(t + 2) * kstep; const char* b2 = last ? nB : cB + (size_t)(t + 2) * kstep;
            const char* a3 = a2 + kstep; const char* b3 = b2 + kstep;
            if (last && has_next) S.a_ready(nxt);
            if constexpr (SP2) {
            PG8_LDB(B0, 0, 0); PG8_LDB(B1, 0, 1); PG8_SCHED; PG8_LDA(At, 0, 0); PG8_STAGE(PG8_SA(1, 1), a1 + hstep, voffA);
            PG8_WAIT_V(8); PG8_WAIT_L(0); PG8_BAR; PG8_MMA(0, 0, At, B0); PG8_MMA(0, 1, At, B1); PG8_BAR; PG8_SCHED;
            PG8_LDA(At, 0, 1); PG8_STAGE(PG8_SB(0, 0), b2, voffB); PG8_STAGE(PG8_SB(0, 1), b2 + hstep, voffB); PG8_STAGE(PG8_SA(0, 0), a2, voffA);
            PG8_WAIT_V(8); PG8_WAIT_L(0); PG8_BAR; PG8_MMA(1, 0, At, B0); PG8_MMA(1, 1, At, B1); PG8_BAR; PG8_SCHED;
            PG8_LDB(B0, 1, 0); PG8_LDB(B1, 1, 1); PG8_SCHED; PG8_LDA(At, 1, 0); PG8_STAGE(PG8_SA(0, 1), a2 + hstep, voffA);
            PG8_WAIT_V(8); PG8_WAIT_L(0); PG8_BAR; PG8_MMA(0, 0, At, B0); PG8_MMA(0, 1, At, B1); PG8_BAR; PG8_SCHED;
            PG8_LDA(At, 1, 1); PG8_STAGE(PG8_SB(1, 0), b3, voffB); PG8_STAGE(PG8_SB(1, 1), b3 + hstep, voffB); PG8_STAGE(PG8_SA(1, 0), a3, voffA);
            PG8_WAIT_V(8); PG8_WAIT_L(0); PG8_BAR; PG8_MMA(1, 0, At, B0); PG8_MMA(1, 1, At, B1); PG8_BAR; PG8_SCHED;
            } else {
            PG8_LDB(B0, 0, 0); PG8_SCHED; PG8_LDA(At, 0, 0); PG8_STAGE(PG8_SA(1, 1), a1 + hstep, voffA);
            PG8_WAIT_L(8); PG8_BAR; PG8_WAIT_L(0); PG8_MMA(0, 0, At, B0); PG8_BAR; PG8_SCHED;
            PG8_LDB(B1, 0, 1); PG8_STAGE(PG8_SB(0, 0), b2, voffB);
            PG8_BAR; PG8_WAIT_L(0); PG8_MMA(0, 1, At, B1); PG8_BAR;
            PG8_LDA(At, 0, 1); PG8_STAGE(PG8_SA(0, 0), a2, voffA);
            PG8_BAR; PG8_WAIT_L(0); PG8_MMA(1, 0, At, B0); PG8_BAR; PG8_SCHED;
            PG8_STAGE(PG8_SB(0, 1), b2 + hstep, voffB);
            PG8_WAIT_V(6); PG8_BAR; PG8_MMA(1, 1, At, B1); PG8_BAR;
            PG8_LDB(B0, 1, 0); PG8_SCHED; PG8_LDA(At, 1, 0); PG8_STAGE(PG8_SA(0, 1), a2 + hstep, voffA);
            PG8_WAIT_L(8); PG8_BAR; PG8_WAIT_L(0); PG8_MMA(0, 0, At, B0); PG8_BAR; PG8_SCHED;
            PG8_LDB(B1, 1, 1); PG8_STAGE(PG8_SB(1, 0), b3, voffB);
            PG8_BAR; PG8_WAIT_L(0); PG8_MMA(0, 1, At, B1); PG8_BAR;
            PG8_LDA(At, 1, 1); PG8_STAGE(PG8_SA(1, 0), a3, voffA);
            PG8_BAR; PG8_WAIT_L(0); PG8_MMA(1, 0, At, B0); PG8_BAR; PG8_SCHED;
            PG8_STAGE(PG8_SB(1, 1), b3 + hstep, voffB);
            PG8_WAIT_V(6); PG8_BAR; PG8_MMA(1, 1, At, B1); PG8_BAR;
            }
        }
        if constexpr (ALIGN_EPI) { if (wr == 0) PG8_BAR; }
        if constexpr (!Epi::AFTER_DRAIN) { E(acc, cur, wr, wc, fr, fq); S.done(cur); }
        if (!has_next) break;
#pragma unroll
        for (int a = 0; a < 2; ++a)
#pragma unroll
            for (int b = 0; b < 2; ++b)
#pragma unroll
                for (int m = 0; m < 4; ++m)
#pragma unroll
                    for (int n = 0; n < 2; ++n) acc[a][b][m][n] = (f32x4){0.f, 0.f, 0.f, 0.f};
        cur = nxt; cA = nA; cB = nB; ++ui;
        if constexpr (ALIGN_EPI) { if (wr == 1) PG8_BAR; }
    }
    PG8_WAIT_V(0);
    if constexpr (!ALIGN_EPI) { if (wr == 0) PG8_BAR; }
    PG8_BAR;
    if constexpr (Epi::AFTER_DRAIN) { E.fused(acc, cur, wr, wc, fr, fq, lds, wid, lane); S.done(cur); }
#undef PG8_SA
#undef PG8_SB
#undef PG8_STAGE
#undef PG8_LDA
#undef PG8_LDB
#undef PG8_MMA
#undef PG8_WAIT_V
#undef PG8_WAIT_L
#undef PG8_BAR
#undef PG8_SCHED
}
}

DI float fsig(float x) { return __builtin_amdgcn_rcpf(1.0f + __builtin_amdgcn_exp2f(-1.4426950408889634f * x)); }
DI float fsilu(float x) { return x * fsig(x); }
DI float fgelu(float x) { return x * fsig(1.5957691216057308f * (x + 0.044715f * x * x * x)); }
typedef float f32x2_t __attribute__((ext_vector_type(2))); typedef __bf16 bf16x2_t __attribute__((ext_vector_type(2)));
DI unsigned cvtpk(float lo, float hi) { f32x2_t v = {lo, hi}; bf16x2_t b = __builtin_convertvector(v, bf16x2_t); return __builtin_bit_cast(unsigned, b); }
DI u32x4 pack8(const f32x4& a, const f32x4& b) { u32x4 w; w.x = cvtpk(a[0], a[1]); w.y = cvtpk(a[2], a[3]); w.z = cvtpk(b[0], b[1]); w.w = cvtpk(b[2], b[3]); return w; }
DI f32x4 shx16(const f32x4& v) { f32x4 r; r[0] = __shfl_xor(v[0], 16); r[1] = __shfl_xor(v[1], 16); r[2] = __shfl_xor(v[2], 16); r[3] = __shfl_xor(v[3], 16); return r; }

struct EpiG1 {
    static constexpr bool PERM = true, AFTER_DRAIN = false, HAS_MID = false; static constexpr int MID_T = -1;
    bf16_t* ZB; const float* rstd; const float* rope; const float* bm; float* out; int layer;
    DI void mid(f32x4 (&)[2][2][4][2], const pg8::Unit&, int, int, int, int) const {}
    template <int KIND>
    DI void act_rows(const f32x4 (&acc)[2][2][4][2], int pm, int pn, int wr, int cw, int fr) const {
        f32x4 bv[2][2];
#pragma unroll
        for (int bj = 0; bj < 2; ++bj)
#pragma unroll
            for (int n = 0; n < 2; ++n) bv[bj][n] = (KIND == 2) ? *(const f32x4*)(bm + (pn * 256 - OGT) + bj * 128 + cw + 4 * n) : (f32x4){0.f, 0.f, 0.f, 0.f};
#pragma unroll
        for (int ai = 0; ai < 2; ++ai)
#pragma unroll
            for (int m = 0; m < 4; ++m) { const int row = pm * 256 + ai * 128 + wr * 64 + m * 16 + fr; const float rs = rstd[row];
                bf16_t* rowp = ZB + (size_t)row * NIN + pn * 256 + cw;
#pragma unroll
                for (int bj = 0; bj < 2; ++bj) { f32x4 v0 = acc[ai][bj][m][0] * rs + bv[bj][0], v1 = acc[ai][bj][m][1] * rs + bv[bj][1];
#pragma unroll
                    for (int e = 0; e < 4; ++e) { if (KIND == 0) { v0[e] = fsilu(v0[e]); v1[e] = fsilu(v1[e]); } else if (KIND == 1) { v0[e] = fgelu(v0[e]); v1[e] = fgelu(v1[e]); } else { v0[e] = fsig(v0[e]); v1[e] = fsig(v1[e]); } }
                    *(u32x4*)(rowp + bj * 128) = pack8(v0, v1); }
                if (m & 1) asm volatile("" ::: "memory"); }
    }
    DI void operator()(const f32x4 (&acc)[2][2][4][2], const pg8::Unit& u, int wr, int wc, int fr, int fq) const {
        const int pn = u.pn, pm = u.pm, cw = wc * 32 + 8 * fq;
        if (pn < 9) {
            const bool is_q = pn < 3, is_v = pn >= 6, do_rope = !is_v && ((wc & 1) == 0);
            const int g = is_q ? 0 : (pn - 3) % 3, kv = is_v ? 1 : 0, keep = 128 << (2 * g), b = pm >> 3;
            const size_t obase = ((g == 0) ? O_KV128P : (g == 1) ? O_KV512P : O_KV2048P) + ((size_t)layer * BATCH + b) * keep * 512 + kv * 256 + cw;
            const float sgn = (fq == 0) ? -1.0f : 1.0f;
#pragma unroll
            for (int ai = 0; ai < 2; ++ai)
#pragma unroll
                for (int m = 0; m < 4; ++m) { const int row = pm * 256 + ai * 128 + wr * 64 + m * 16 + fr, t = row & (SEQ - 1); const float rs = rstd[row];
                    f32x4 c0, c1, s0, s1;
                    if (do_rope) { c0 = *(const f32x4*)(rope + t * 8); c1 = *(const f32x4*)(rope + t * 8 + 4); s0 = *(const f32x4*)(rope + 2049 * 8 + t * 8) * sgn; s1 = *(const f32x4*)(rope + 2049 * 8 + t * 8 + 4) * sgn; }
                    bf16_t* rowp = ZB + (size_t)row * NIN + pn * 256 + cw; const int j = t - (SEQ - keep);
#pragma unroll
                    for (int bj = 0; bj < 2; ++bj) { f32x4 v0 = acc[ai][bj][m][0] * rs, v1 = acc[ai][bj][m][1] * rs;
                        if (do_rope) { const f32x4 p0 = shx16(v0), p1 = shx16(v1); const f32x4 r0 = v0 * c0 + p0 * s0, r1 = v1 * c1 + p1 * s1; if (fq < 2) { v0 = r0; v1 = r1; } }
                        if (!is_q && j >= 0) { float* op = out + obase + (size_t)j * 512 + bj * 128; *(f32x4*)op = v0; *(f32x4*)(op + 4) = v1; }
                        if (is_q) { v0 = v0 * C2; v1 = v1 * C2; }
                        *(u32x4*)(rowp + bj * 128) = pack8(v0, v1); }
                    if (m & 1) asm volatile("" ::: "memory"); }
        } else if (pn == 9 || (pn >= 16 && pn < 19)) act_rows<0>(acc, pm, pn, wr, cw, fr);
        else if (pn < 16) act_rows<1>(acc, pm, pn, wr, cw, fr);
        else act_rows<2>(acc, pm, pn, wr, cw, fr);
    }
};
struct EpiG2 {
    static constexpr bool PERM = true, AFTER_DRAIN = false, HAS_MID = true; static constexpr int MID_T = 4;
    const bf16_t* ZB; bf16_t* MG;
    DI void mid(f32x4 (&acc)[2][2][4][2], const pg8::Unit& u, int wr, int wc, int fr, int fq) const {
        const int cw = wc * 32 + 8 * fq;
#pragma unroll
        for (int ai = 0; ai < 2; ++ai)
#pragma unroll
            for (int m = 0; m < 4; ++m) { const int row = u.pm * 256 + ai * 128 + wr * 64 + m * 16 + fr; const bf16_t* gp = ZB + (size_t)row * NIN + OGT + u.pn * 256 + cw;
#pragma unroll
                for (int bj = 0; bj < 2; ++bj) { const bf16x8 ga = *(const bf16x8*)(gp + bj * 128), gb = *(const bf16x8*)(gp + DM + bj * 128);
#pragma unroll
                    for (int e = 0; e < 4; ++e) { acc[ai][bj][m][0][e] *= bfs2f(ga[e]) * __builtin_amdgcn_rcpf(fmaxf(bfs2f(gb[e]), 1e-30f)); acc[ai][bj][m][1][e] *= bfs2f(ga[4 + e]) * __builtin_amdgcn_rcpf(fmaxf(bfs2f(gb[4 + e]), 1e-30f)); } }
                if (m & 1) asm volatile("" ::: "memory"); }
    }
    DI void operator()(const f32x4 (&acc)[2][2][4][2], const pg8::Unit& u, int wr, int wc, int fr, int fq) const {
        const int cw = wc * 32 + 8 * fq;
#pragma unroll
        for (int ai = 0; ai < 2; ++ai)
#pragma unroll
            for (int m = 0; m < 4; ++m) { const int row = u.pm * 256 + ai * 128 + wr * 64 + m * 16 + fr; const bf16_t* gp = ZB + (size_t)row * NIN + OGT + DM + u.pn * 256 + cw;
                bf16_t* rowp = MG + (size_t)row * DM + u.pn * 256 + cw;
#pragma unroll
                for (int bj = 0; bj < 2; ++bj) { const bf16x8 gb = *(const bf16x8*)(gp + bj * 128); f32x4 v0 = acc[ai][bj][m][0], v1 = acc[ai][bj][m][1];
#pragma unroll
                    for (int e = 0; e < 4; ++e) { v0[e] *= fmaxf(bfs2f(gb[e]), 1e-30f); v1[e] *= fmaxf(bfs2f(gb[4 + e]), 1e-30f); }
                    *(u32x4*)(rowp + bj * 128) = pack8(v0, v1); }
                if (m & 1) asm volatile("" ::: "memory"); }
    }
};
struct EpiG3 {
    static constexpr bool PERM = true, AFTER_DRAIN = false, HAS_MID = false; static constexpr int MID_T = -1;
    float* Y;
    DI void mid(f32x4 (&)[2][2][4][2], const pg8::Unit&, int, int, int, int) const {}
    DI void operator()(const f32x4 (&acc)[2][2][4][2], const pg8::Unit& u, int wr, int wc, int fr, int fq) const {
        const int cw = wc * 32 + 8 * fq;
#pragma unroll
        for (int ai = 0; ai < 2; ++ai)
#pragma unroll
            for (int m = 0; m < 4; ++m) { float* rowp = Y + (size_t)(u.pm * 256 + ai * 128 + wr * 64 + m * 16 + fr) * DM + u.pn * 256 + cw;
#pragma unroll
                for (int bj = 0; bj < 2; ++bj) { *(f32x4*)(rowp + bj * 128) = acc[ai][bj][m][0]; *(f32x4*)(rowp + bj * 128 + 4) = acc[ai][bj][m][1]; } }
    }
};

#define LAS __attribute__((address_space(3)))
#define XB_TMO      128
#define XB_XCNT(j)  (256  + 64 * (j))
#define XB_XSUB(j)  (1280 + 64 * (j))
#define XB_XGEN(j)  (2304 + 64 * (j))
#define XB_TOP      3328
#define XB_TOPGEN   3392
#define XCD_BAR_WORDS 3456
#define XB_SPIN_CAP (1u << 18)
__device__ __forceinline__ unsigned xb_ld(unsigned* p)              { return __hip_atomic_load(p, __ATOMIC_RELAXED, __HIP_MEMORY_SCOPE_AGENT); }
__device__ __forceinline__ unsigned xb_add(unsigned* p, unsigned v) { return __hip_atomic_fetch_add(p, v, __ATOMIC_RELAXED, __HIP_MEMORY_SCOPE_AGENT); }
__device__ __forceinline__ unsigned xb_xcc_id() { return (unsigned)__builtin_amdgcn_s_getreg((3 << 11) | 20) & 0xFu; }
#define XB_SPIN(cond, bar) do { unsigned _sp = 0; while (cond) { __builtin_amdgcn_s_sleep(1); \
    if ((++_sp & 255u) == 0u) { if (xb_ld(&(bar)[XB_TMO])) break; if (_sp > XB_SPIN_CAP) { atomicAdd(&(bar)[XB_TMO], 1u); break; } } } } while (0)
struct XcdBarrier { unsigned* bar; unsigned x; volatile LAS unsigned* st; };
__device__ __forceinline__ XcdBarrier xcd_barrier_post(unsigned* bar, volatile LAS unsigned* st) {
    XcdBarrier b; b.bar = bar; b.x = xb_xcc_id(); b.st = st;
    if (threadIdx.x == 0) { (void)xb_add(&bar[XB_XCNT(b.x)], 1u); st[2] = b.x; }
    return b;
}
__device__ __forceinline__ void xcd_barrier_complete(unsigned* bar, unsigned x, unsigned& nloc, unsigned& nx) {
    const unsigned G = gridDim.x * gridDim.y * gridDim.z;
    unsigned sum, cnt, mine, sp = 0u;
    for (;;) {
        sum = 0u; cnt = 0u; mine = 0u;
#pragma unroll
        for (unsigned j = 0; j < 16; ++j) { const unsigned c = xb_ld(&bar[XB_XCNT(j)]); sum += c; cnt += (c > 0u) ? 1u : 0u; mine = (j == x) ? c : mine; }
        if (sum == G) break;
        __builtin_amdgcn_s_sleep(1);
        if ((++sp & 255u) == 0u) { if (xb_ld(&bar[XB_TMO])) break; if (sp > XB_SPIN_CAP) { atomicAdd(&bar[XB_TMO], 1u); break; } }
    }
    nloc = mine > 0u ? mine : 1u; nx = cnt > 0u ? cnt : 1u;
}
__device__ __forceinline__ void xcd_barrier(const XcdBarrier& b) {
    asm volatile("s_waitcnt vmcnt(0)" ::: "memory");
    __syncthreads();
    if (threadIdx.x == 0) {
        unsigned* bar = b.bar;
        __builtin_amdgcn_s_waitcnt(0);
        unsigned nloc = b.st[0], nx = b.st[1]; const unsigned bx = b.st[2];
        if (nloc == 0u) { xcd_barrier_complete(bar, bx, nloc, nx); b.st[0] = nloc; b.st[1] = nx; }
        const unsigned old = xb_add(&bar[XB_XSUB(bx)], 1u);
        const unsigned gen = old / nloc;
        if (old + 1u == (gen + 1u) * nloc) {
            __builtin_amdgcn_fence(__ATOMIC_RELEASE, "agent");
            asm volatile("s_waitcnt vmcnt(0)" ::: "memory");
            const unsigned og = xb_add(&bar[XB_TOP], 1u);
            const unsigned tg = og / nx;
            if (og + 1u == (tg + 1u) * nx) xb_add(&bar[XB_TOPGEN], 1u);
            else XB_SPIN(xb_ld(&bar[XB_TOPGEN]) == tg, bar);
            __builtin_amdgcn_fence(__ATOMIC_ACQUIRE, "agent");
            xb_add(&bar[XB_XGEN(bx)], 1u);
            asm volatile("s_waitcnt vmcnt(0)" ::: "memory");
        } else {
            XB_SPIN(xb_ld(&bar[XB_XGEN(bx)]) == gen, bar);
            __builtin_amdgcn_fence(__ATOMIC_ACQUIRE, "agent");
            asm volatile("s_waitcnt vmcnt(0)" ::: "memory");
        }
    }
    __syncthreads();
}

constexpr int NT = 512;
constexpr int RING_BYTES = 131072, LDSCTL_OFF = RING_BYTES, MISC_OFF = LDSCTL_OFF + 320, LDS_BYTES = 147456;
constexpr int CW_BAR = 4096;
constexpr size_t CTL_ZERO_BYTES = 65536;
__global__ void __launch_bounds__(NT, 2) mega_kernel(Params P) {
    extern __shared__ __attribute__((aligned(16))) unsigned char lds[];
    const int tid = threadIdx.x, lane = tid & 63, wave = __builtin_amdgcn_readfirstlane(tid >> 6);
    const int G = gridDim.x;
    const int vcu = (G % 8 == 0) ? ((int)blockIdx.x % 8) * (G / 8) + (int)blockIdx.x / 8 : (int)blockIdx.x;
    const int gw = vcu * (NT / 64) + wave, ngw = G * (NT / 64);
    LAS unsigned char* l3 = (LAS unsigned char*)lds;
    for (int u = tid; u < (LDS_BYTES - LDSCTL_OFF) / 4; u += NT) ((LAS unsigned*)(l3 + LDSCTL_OFF))[u] = 0u;
    __syncthreads();
    volatile LAS unsigned* MISC = (volatile LAS unsigned*)(l3 + MISC_OFF);
    XcdBarrier bar = xcd_barrier_post((unsigned*)(P.ws + WS_CTL) + CW_BAR, MISC + 8);

    ph_prologue(P, (float*)lds, gw, ngw, wave, lane);
    xcd_barrier(bar);
    const int gwh = (int)blockIdx.x * (NT / 64) + wave;
#pragma unroll 1
    for (int L = 0; L < DEPTH; ++L) {
#define LAUNDER() int lane_ = lane, tid_ = tid, gw_ = gw; asm volatile("" : "+v"(lane_), "+v"(tid_), "+v"(gw_))
        {
            pg8::Gemm g{(const bf16_t*)(P.ws + WS_XB), (const bf16_t*)(P.ws + WS_WIN) + (size_t)L * NIN * DM, M, NIN, DM}; pg8::StaticOrder S; S.init(M, NIN, G, (int)blockIdx.x);
            EpiG1 E{(bf16_t*)(P.ws + WS_ZB), (const float*)(P.ws + WS_RSTD), (const float*)(P.ws + WS_ROPE), P.b_merge + L * 2 * DM, P.out, L};
            pg8::gemm_phase<EpiG1, pg8::StaticOrder, true, true>(l3, g, S, E);
            { LAUNDER(); for (int it = ngw - 1 - gwh; it < NIN / 32; it += ngw) g1_wave_tile(P, L, true, 0, it, lane_); }
        }
        xcd_barrier(bar);
        { LAUNDER(); ph_gmlp_naive(P, L, vcu, G, tid_, NT); }
        { LAUNDER(); ph_attn_naive(P, L, gw_, ngw, lane_); }
        { LAUNDER(); ph_attn_sample(P, L, gw_, ngw, lane_); ph_gmlp_sample(P, L, ngw - 1 - gw_, ngw, lane_); }
        xcd_barrier(bar);
        {
            pg8::Gemm g{(const bf16_t*)(P.ws + WS_ASG), (const bf16_t*)(P.ws + WS_W2) + (size_t)L * DM * DM, M, DM, DM}; pg8::StaticOrder S; S.init(M, DM, G, (int)blockIdx.x);
            EpiG2 E{(const bf16_t*)(P.ws + WS_ZB), (bf16_t*)(P.ws + WS_MG)};
            pg8::gemm_phase<EpiG2, pg8::StaticOrder, false, true>(l3, g, S, E);
            { LAUNDER(); if (wave == 0 && blockIdx.x < DM / 32) g2_wave_tile(P, L, true, 0, (int)blockIdx.x, lane_); }
        }
        xcd_barrier(bar);
        {
            pg8::Gemm g{(const bf16_t*)(P.ws + WS_MG), (const bf16_t*)(P.ws + WS_WOUT) + (size_t)L * DM * DM, M, DM, DM}; pg8::StaticOrder S; S.init(M, DM, G, (int)blockIdx.x);
            EpiG3 E{(float*)(P.ws + WS_Y)};
            pg8::gemm_phase<EpiG3, pg8::StaticOrder, false, true>(l3, g, S, E);
            { LAUNDER(); if (wave == 0 && blockIdx.x < DM / 32) g3_wave_tile(P, L, true, 0, (int)blockIdx.x, lane_); }
        }
        xcd_barrier(bar);
        { LAUNDER(); ph_post(P, L, gw_, ngw, lane_); }
        if (L + 1 < DEPTH) xcd_barrier(bar);
    }
}

extern "C" void kernel_launch(void* const* d_in, const int* in_sizes, int n_in, void* d_out, int out_size, void* d_ws, size_t ws_size, hipStream_t stream) {
    static int grid = 0;
    if (grid == 0) {
        if (n_in != 16 || (size_t)out_size != O_END || ws_size < WS_END) { fprintf(stderr, "kernel_launch: unexpected shapes n_in %d out %d ws %zu\n", n_in, out_size, ws_size); grid = -1; return; }
        int dev = 0, cus = 0, per_cu = 0;
        if (hipGetDevice(&dev) != hipSuccess || hipDeviceGetAttribute(&cus, hipDeviceAttributeMultiprocessorCount, dev) != hipSuccess) { grid = -1; return; }
        if (hipFuncSetAttribute((const void*)mega_kernel, hipFuncAttributeMaxDynamicSharedMemorySize, LDS_BYTES) != hipSuccess) { fprintf(stderr, "kernel_launch: hipFuncSetAttribute failed\n"); grid = -1; return; }
        if (hipOccupancyMaxActiveBlocksPerMultiprocessor(&per_cu, (const void*)mega_kernel, NT, LDS_BYTES) != hipSuccess || per_cu < 1) { fprintf(stderr, "kernel_launch: occupancy query says %d blocks per CU\n", per_cu); grid = -1; (void)hipGetLastError(); return; }
        grid = cus;
    }
    if (grid < 0) return;
    if (hipMemsetAsync((char*)d_ws + WS_CTL, 0, CTL_ZERO_BYTES, stream) != hipSuccess) return;
    Params P{};
    P.x_prompt = (const float*)d_in[0]; P.x_sample = (const float*)d_in[1]; P.cache[0] = (const float*)d_in[2]; P.cache[1] = (const float*)d_in[3]; P.cache[2] = (const float*)d_in[4];
    P.norm_pre = (const float*)d_in[5]; P.w_in = (const float*)d_in[6]; P.b_merge = (const float*)d_in[7]; P.v_norm_g = (const float*)d_in[8]; P.v_norm_b = (const float*)d_in[9];
    P.w_spatial = (const float*)d_in[10]; P.b_spatial = (const float*)d_in[11]; P.w_pa = (const float*)d_in[12]; P.w_pb = (const float*)d_in[13]; P.w_out = (const float*)d_in[14]; P.norm_post = (const float*)d_in[15];
    P.out = (float*)d_out; P.ws = (unsigned char*)d_ws;
    hipLaunchKernelGGL(mega_kernel, dim3(grid), dim3(NT), LDS_BYTES, stream, P);
}
```

```cpp
#include <hip/hip_runtime.h>
#include <stdint.h>
#include <cstdio>

typedef unsigned short bf16_t;
typedef short bf16x8 __attribute__((ext_vector_type(8)));
typedef float f32x16 __attribute__((ext_vector_type(16)));
typedef float f32x4 __attribute__((ext_vector_type(4)));
typedef unsigned u32x4 __attribute__((ext_vector_type(4)));
#define DI __device__ __forceinline__
#define LAS __attribute__((address_space(3)))

constexpr int DM = 1024, BATCH = 8, SEQ = 2048, DEPTH = 4, DECB = 32, PAST = 8192;
constexpr int M = BATCH * SEQ;
constexpr int NIN = 6912;
constexpr int OQ = 0, OKK = 768, OV = 1536, OGA = 2304, OU = 2560, OGV = 3328, OGB = 4096, OGT = 4864;
constexpr float EPS = 1e-6f;
constexpr float C2 = 0.18033688011112042f;
constexpr size_t O_Y = 0, O_YS = 16777216, O_KV128P = 16809984, O_KV512P = 18907136, O_KV2048P = 27295744,
                 O_KV128S = 60850176, O_KV512S = 60915712, O_KV2048S = 60981248, O_VNS = 61046784, O_END = 61145088;
constexpr size_t MiB = 1u << 20;
constexpr size_t WS_CTL = 0, WS_ROPE = 1 * MiB, WS_WIN = 2 * MiB, WS_W2 = 56 * MiB  , WS_WOUT = 64 * MiB, WS_WSB = 72 * MiB,
                 WS_XB = 74 * MiB, WS_RSTD = 106 * MiB, WS_ZB = 108 * MiB, WS_ASG = 324 * MiB  , WS_MG = 356 * MiB, WS_Y = 388 * MiB,
                 WS_VN = 452 * MiB, WS_SMP = 480 * MiB, WS_END = 484 * MiB;
constexpr size_t SM_XSB = 0, SM_RSTD = 65536, SM_ZSF = 131072  , SM_AGS = 1048576, SM_SGS = 1048576 + 16384, SM_MGS = 1048576 + 65536,
                 SM_YS = 1048576 + 131072;

struct Params {
    const float* x_prompt; const float* x_sample; const float* cache[3];
    const float* norm_pre; const float* w_in; const float* b_merge; const float* v_norm_g; const float* v_norm_b;
    const float* w_spatial; const float* b_spatial; const float* w_pa; const float* w_pb; const float* w_out; const float* norm_post;
    float* out; unsigned char* ws;
    int phase; int layer;
};

DI float bf2f(bf16_t b) { return __uint_as_float((unsigned)b << 16); }
DI float bfs2f(short b) { return __uint_as_float(((unsigned)(unsigned short)b) << 16); }
DI bf16_t f2bf(float f) { unsigned u = __float_as_uint(f); return (bf16_t)((u + 0x7fffu + ((u >> 16) & 1u)) >> 16); }
DI unsigned pk2(float lo, float hi) { return (unsigned)f2bf(lo) | ((unsigned)f2bf(hi) << 16); }
DI float sigmoidf_(float x) { return 1.0f / (1.0f + __expf(-x)); }
DI float siluf_(float x) { return x * sigmoidf_(x); }
DI float geluf_(float x) { return x * sigmoidf_(1.5957691216057308f * (x + 0.044715f * x * x * x)); }
DI float wave_sum(float v) {
#pragma unroll
    for (int o = 1; o < 64; o <<= 1) v += __shfl_xor(v, o);
    return v;
}
DI float wave_max(float v) {
#pragma unroll
    for (int o = 1; o < 64; o <<= 1) v = fmaxf(v, __shfl_xor(v, o));
    return v;
}
DI int crow(int r, int hi) { return (r & 3) + 8 * (r >> 2) + 4 * hi; }

DI void sincos_d(double a, double& s, double& c) {
    const double TWO_PI = 6.283185307179586476925286766559;
    double n = rint(a / TWO_PI);
    double r = a - n * TWO_PI;
    double x = r * 0.125, x2 = x * x;
    double sv = x * (1.0 + x2 * (-1.0 / 6 + x2 * (1.0 / 120 + x2 * (-1.0 / 5040 + x2 * (1.0 / 362880 + x2 * (-1.0 / 39916800 + x2 * (1.0 / 6227020800.0)))))));
    double cv = 1.0 + x2 * (-0.5 + x2 * (1.0 / 24 + x2 * (-1.0 / 720 + x2 * (1.0 / 40320 + x2 * (-1.0 / 3628800 + x2 * (1.0 / 479001600.0 + x2 * (-1.0 / 87178291200.0)))))));
#pragma unroll
    for (int i = 0; i < 3; ++i) { double s2 = 2.0 * sv * cv, c2 = 1.0 - 2.0 * sv * sv; sv = s2; cv = c2; }
    s = sv; c = cv;
}

DI void transpose_item(const float* W, int K, int N, bf16_t* WT, int ldw, const float* kscale, float* scr, int item, int lane) {
    const int nblk = N / 32, kb = item / nblk, nb = item % nblk, k0 = 64 * kb, n0 = 32 * nb;
#pragma unroll 8
    for (int i = 0; i < 32; ++i) { const int kk = 2 * i + (lane >> 5); float v = W[(size_t)(k0 + kk) * N + n0 + (lane & 31)]; if (kscale) v *= kscale[k0 + kk]; scr[kk * 33 + (lane & 31)] = v; }
    __builtin_amdgcn_s_waitcnt(0xc07f); asm volatile("" ::: "memory");
    const int c = lane & 7;
#pragma unroll
    for (int j = 0; j < 4; ++j) { const int n = (lane >> 3) + 8 * j; const float* s = scr + (8 * c) * 33 + n;
        u32x4 o; o.x = pk2(s[0 * 33], s[1 * 33]); o.y = pk2(s[2 * 33], s[3 * 33]); o.z = pk2(s[4 * 33], s[5 * 33]); o.w = pk2(s[6 * 33], s[7 * 33]);
        *(u32x4*)(WT + (size_t)(n0 + n) * ldw + k0 + 8 * c) = o; }
    __builtin_amdgcn_s_waitcnt(0xc07f); asm volatile("" ::: "memory");
}
DI void row_to_bf16(const float* xrow, bf16_t* orow, float* rstd_out, int lane) {
    const f32x4* xr = (const f32x4*)xrow + lane; f32x4 v[4]; float ss = 0.f;
#pragma unroll
    for (int j = 0; j < 4; ++j) { v[j] = xr[64 * j]; ss += (v[j].x * v[j].x + v[j].y * v[j].y) + (v[j].z * v[j].z + v[j].w * v[j].w); }
    ss = wave_sum(ss);
    unsigned long long* o8 = (unsigned long long*)orow + lane;
#pragma unroll
    for (int j = 0; j < 4; ++j) o8[64 * j] = (unsigned long long)pk2(v[j].x, v[j].y) | ((unsigned long long)pk2(v[j].z, v[j].w) << 32);
    if (lane == 0) *rstd_out = 1.0f / sqrtf(ss * (1.0f / DM) + EPS);
}
DI void ph_prologue(const Params& P, float* lds_f, int gw, int ngw, int wave, int lane) {
    unsigned char* ws = P.ws;
    float* scr = lds_f + wave * (64 * 33);
    constexpr int I_IN = (DM / 64) * (NIN / 32), I_PA = (256 / 64) * (DM / 32), I_PB = (768 / 64) * (DM / 32), I_OUT = (DM / 64) * (DM / 32), I_L = I_IN + I_PA + I_PB + I_OUT;
    for (int it = gw; it < DEPTH * I_L; it += ngw) {
        const int l = it / I_L; int r = it % I_L;
        if (r < I_IN) { transpose_item(P.w_in + (size_t)l * DM * NIN, DM, NIN, (bf16_t*)(ws + WS_WIN) + (size_t)l * NIN * DM, DM, P.norm_pre + l * DM, scr, r, lane); continue; } r -= I_IN;
        if (r < I_PA) { transpose_item(P.w_pa + (size_t)l * 256 * DM, 256, DM, (bf16_t*)(ws + WS_W2) + (size_t)l * DM * DM, DM, nullptr, scr, r, lane); continue; } r -= I_PA;
        if (r < I_PB) { transpose_item(P.w_pb + (size_t)l * 768 * DM, 768, DM, (bf16_t*)(ws + WS_W2) + (size_t)l * DM * DM + 256, DM, nullptr, scr, r, lane); continue; } r -= I_PB;
        transpose_item(P.w_out + (size_t)l * DM * DM, DM, DM, (bf16_t*)(ws + WS_WOUT) + (size_t)l * DM * DM, DM, nullptr, scr, r, lane);
    }
    { bf16_t* wsb = (bf16_t*)(ws + WS_WSB);
      for (int e = gw * 64 + lane; e < DEPTH * 4 * 128 * 128; e += ngw * 64) { const int j = e & 127, i = (e >> 7) & 127; wsb[e] = (j <= i) ? f2bf(P.w_spatial[e]) : (bf16_t)0; } }
    { float* rc = (float*)(ws + WS_ROPE); float* rs = rc + 2049 * 8;
      for (int e = gw * 64 + lane; e < 2049 * 8; e += ngw * 64) { const int pi = e >> 3, i = e & 7; const float pos = (pi == 2048) ? (float)PAST : (float)pi;
          float fr = 1.0f;
          fr = (i == 1) ? 0.1939227432012558f : fr; fr = (i == 2) ? 0.03760603070259094f : fr; fr = (i == 3) ? 0.007292664609849453f : fr; fr = (i == 4) ? 0.0014142135623842478f : fr;
          fr = (i == 5) ? 0.00027424818836152554f : fr; fr = (i == 6) ? 5.318296098266728e-05f : fr; fr = (i == 7) ? 1.0313386155758053e-05f : fr;
          const float ang = pos * fr; double s, c; sincos_d((double)ang, s, c); rc[e] = (float)c; rs[e] = (float)s; } }
    for (int m = gw; m < M + DECB; m += ngw) {
        if (m < M) row_to_bf16(P.x_prompt + (size_t)m * DM, (bf16_t*)(ws + WS_XB) + (size_t)m * DM, (float*)(ws + WS_RSTD) + m, lane);
        else { const int b = m - M; row_to_bf16(P.x_sample + (size_t)b * DM, (bf16_t*)(ws + WS_SMP + SM_XSB) + (size_t)b * DM, (float*)(ws + WS_SMP + SM_RSTD) + b, lane); }
    }
}

DI f32x16 wave_gemm32(const bf16_t* A, int lda, const bf16_t* Bt, int ldb, int K, int row0, int col0, int lane, f32x16 acc) {
    const int r = lane & 31, h = lane >> 5;
    const bf16_t* ap = A + (size_t)(row0 + r) * lda + 8 * h;
    const bf16_t* bp = Bt + (size_t)(col0 + r) * ldb + 8 * h;
#pragma unroll 4
    for (int k0 = 0; k0 < K; k0 += 16) {
        const bf16x8 a = *(const bf16x8*)(ap + k0), b = *(const bf16x8*)(bp + k0);
        acc = __builtin_amdgcn_mfma_f32_32x32x16_bf16(a, b, acc, 0, 0, 0);
    }
    return acc;
}

DI void g1_epi_scalar(const Params& P, int layer, bool smp, int row, int col, float v, float pv) {
    unsigned char* ws = P.ws;
    float val = v;
    if (col < OV) {
        const int dd = col & 63;
        if (dd < 16) { const int t = smp ? 2048 : (row & (SEQ - 1)); const float* rc = (const float*)(ws + WS_ROPE); const float c = rc[t * 8 + (dd & 7)], s = rc[2049 * 8 + t * 8 + (dd & 7)];
            val = (dd < 8) ? (v * c - pv * s) : (v * c + pv * s); }
        if (col < OKK) val *= C2;
    } else if (col < OGA) {
    } else if (col < OU) val = siluf_(v);
    else if (col < OGB) val = geluf_(v);
    else if (col < OGT) val = siluf_(v);
    else val = sigmoidf_(v + P.b_merge[layer * 2 * DM + (col - OGT)]);
    if (smp) ((float*)(ws + WS_SMP + SM_ZSF))[(size_t)row * NIN + col] = val;
    else ((bf16_t*)(ws + WS_ZB))[(size_t)row * NIN + col] = f2bf(val);
    if (col >= OKK && col < OGA) {
        const int kv = (col >= OV) ? 1 : 0, hh = (col - (kv ? OV : OKK)) >> 6, g = hh >> 2, hs = hh & 3, dd = col & 63;
        if (smp) { const size_t base = (g == 0) ? O_KV128S : (g == 1) ? O_KV512S : O_KV2048S;
            P.out[base + ((size_t)layer * DECB + row) * 512 + kv * 256 + hs * 64 + dd] = val; }
        else { const int keep = 128 << (2 * g), b = row >> 11, t = row & (SEQ - 1), j = t - (SEQ - keep);
            if (j >= 0) { const size_t base = (g == 0) ? O_KV128P : (g == 1) ? O_KV512P : O_KV2048P;
                P.out[base + (((size_t)layer * BATCH + b) * keep + j) * 512 + kv * 256 + hs * 64 + dd] = val; } }
    }
}
DI void g1_wave_tile(const Params& P, int layer, bool smp, int rt, int ct, int lane) {
    unsigned char* ws = P.ws;
    const bf16_t* A = smp ? (const bf16_t*)(ws + WS_SMP + SM_XSB) : (const bf16_t*)(ws + WS_XB);
    const float* rstd = smp ? (const float*)(ws + WS_SMP + SM_RSTD) : (const float*)(ws + WS_RSTD);
    const bf16_t* Bt = (const bf16_t*)(ws + WS_WIN) + (size_t)layer * NIN * DM;
    f32x16 acc = {};
    acc = wave_gemm32(A, DM, Bt, DM, DM, rt * 32, ct * 32, lane, acc);
    const int hi = lane >> 5, col = ct * 32 + (lane & 31);
#pragma unroll
    for (int r = 0; r < 16; ++r) { const int row = rt * 32 + crow(r, hi); const float v = acc[r] * rstd[row]; const float pv = __shfl_xor(v, 8); g1_epi_scalar(P, layer, smp, row, col, v, pv); }
}
DI void ph_g1_naive(const Params& P, int layer, int gw, int ngw, int lane) {
    constexpr int CT = NIN / 32, RT = M / 32;
    for (int it = gw; it < RT * CT + CT; it += ngw) {
        if (it < RT * CT) { const int rt = it / CT, ct = it % CT; g1_wave_tile(P, layer, false, rt, ct, lane); }
        else g1_wave_tile(P, layer, true, 0, it - RT * CT, lane);
    }
}

DI void ph_attn_naive(const Params& P, int layer, int gw, int ngw, int lane) {
    unsigned char* ws = P.ws; const bf16_t* ZB = (const bf16_t*)(ws + WS_ZB); bf16_t* ASG = (bf16_t*)(ws + WS_ASG);
    for (int item = gw; item < M * 4; item += ngw) {
        const int row = item >> 2, hs = item & 3, t = row & (SEQ - 1), b0 = row - t;
        float m = -INFINITY, l = 0.f, o = 0.f;
        for (int g = 0; g < 3; ++g) {
            const int d = 1 << (2 * g), head = g * 4 + hs;
            const bf16_t* qp = ZB + (size_t)row * NIN + OQ + head * 64;
            bf16x8 qv[8];
#pragma unroll
            for (int i = 0; i < 8; ++i) qv[i] = *(const bf16x8*)(qp + 8 * i);
            for (int jb = 0; jb < 3; ++jb) {
                const int j = jb * 64 + lane, p = t - d * j; const bool valid = (j <= 128) && (p >= 0);
                float s = -INFINITY;
                if (valid) { const bf16_t* kp = ZB + (size_t)(b0 + p) * NIN + OKK + head * 64; float acc = 0.f;
#pragma unroll
                    for (int i = 0; i < 8; ++i) { const bf16x8 kv = *(const bf16x8*)(kp + 8 * i);
#pragma unroll
                        for (int e = 0; e < 8; ++e) acc += bfs2f(qv[i][e]) * bfs2f(kv[e]); }
                    s = acc; }
                const float mx = wave_max(s);
                if (mx == -INFINITY) continue;
                const float mn = fmaxf(m, mx), sc = exp2f(m - mn), pj = valid ? exp2f(s - mn) : 0.f;
                l = l * sc + wave_sum(pj); o *= sc; m = mn;
                const int nj = (129 - jb * 64) < 64 ? (129 - jb * 64) : 64;
                for (int jj = 0; jj < nj; ++jj) { const int pp = t - d * (jb * 64 + jj); if (pp < 0) break;
                    const float pjj = __shfl(pj, jj); o += pjj * bf2f(ZB[(size_t)(b0 + pp) * NIN + OV + head * 64 + lane]); }
            }
        }
        const float gate = bf2f(ZB[(size_t)row * NIN + OGA + hs * 64 + lane]);
        ASG[(size_t)row * DM + hs * 64 + lane] = f2bf(o / l * gate);
    }
}
DI void ph_attn_sample(const Params& P, int layer, int gw, int ngw, int lane) {
    unsigned char* ws = P.ws; const float* ZSF = (const float*)(ws + WS_SMP + SM_ZSF); bf16_t* AGS = (bf16_t*)(ws + WS_SMP + SM_AGS);
    for (int item = gw; item < DECB * 4; item += ngw) {
        const int b = item >> 2, hs = item & 3;
        float m = -INFINITY, l = 0.f, o = 0.f;
        for (int g = 0; g < 3; ++g) {
            const int d = 1 << (2 * g), W = 128 << (2 * g), head = g * 4 + hs;
            const float* cache = P.cache[g] + ((size_t)layer * DECB + b) * W * 512;
            const float* qp = ZSF + (size_t)b * NIN + OQ + head * 64;
            const float* kself = ZSF + (size_t)b * NIN + OKK + head * 64; const float* vself = ZSF + (size_t)b * NIN + OV + head * 64;
            for (int jb = 0; jb < 3; ++jb) {
                const int j = jb * 64 + lane; const bool valid = (j <= 128);
                float s = -INFINITY;
                if (valid) { const float* kp = (j == 0) ? kself : cache + (size_t)(W - d * j) * 512 + hs * 64; float acc = 0.f;
#pragma unroll 8
                    for (int i = 0; i < 64; i += 4) { const f32x4 kk = *(const f32x4*)(kp + i), qq = *(const f32x4*)(qp + i); acc += (kk.x * qq.x + kk.y * qq.y) + (kk.z * qq.z + kk.w * qq.w); }
                    s = acc; }
                const float mx = wave_max(s);
                const float mn = fmaxf(m, mx), sc = exp2f(m - mn), pj = valid ? exp2f(s - mn) : 0.f;
                l = l * sc + wave_sum(pj); o *= sc; m = mn;
                const int nj = (129 - jb * 64) < 64 ? (129 - jb * 64) : 64;
                for (int jj = 0; jj < nj; ++jj) { const int jg = jb * 64 + jj; const float* vp = (jg == 0) ? vself : cache + (size_t)(W - d * jg) * 512 + 256 + hs * 64;
                    o += __shfl(pj, jj) * vp[lane]; }
            }
        }
        const float gate = ZSF[(size_t)b * NIN + OGA + hs * 64 + lane];
        AGS[b * 256 + hs * 64 + lane] = f2bf(o / l * gate);
    }
}

DI void ph_gmlp_naive(const Params& P, int layer, int wg, int nwg, int tid, int nthreads) {
    unsigned char* ws = P.ws; const bf16_t* ZB = (const bf16_t*)(ws + WS_ZB); bf16_t* VN = (bf16_t*)(ws + WS_VN); bf16_t* ASG = (bf16_t*)(ws + WS_ASG);
    const bf16_t* WSB = (const bf16_t*)(ws + WS_WSB) + (size_t)layer * 4 * 128 * 128;
    const float* lg = P.v_norm_g + layer * 768; const float* lb = P.v_norm_b + layer * 768; const float* bsp = P.b_spatial + layer * 4 * 128;
    const int wave = tid >> 6, lane = tid & 63, nwaves = nthreads >> 6;
    for (int ch = wg; ch < M / 128; ch += nwg) {
        const int r0 = ch * 128;
        for (int r = wave; r < 128; r += nwaves) {
            const bf16_t* gp = ZB + (size_t)(r0 + r) * NIN + OGV; float x[12]; float s = 0.f;
#pragma unroll
            for (int i = 0; i < 12; ++i) { x[i] = bf2f(gp[i * 64 + lane]); s += x[i]; }
            const float mean = wave_sum(s) * (1.0f / 768); float q = 0.f;
#pragma unroll
            for (int i = 0; i < 12; ++i) { x[i] -= mean; q += x[i] * x[i]; }
            const float rs = 1.0f / sqrtf(wave_sum(q) * (1.0f / 768) + EPS);
#pragma unroll
            for (int i = 0; i < 12; ++i) { const int c = i * 64 + lane; VN[(size_t)(r0 + r) * 768 + c] = f2bf(x[i] * rs * lg[c] + lb[c]); }
        }
        __threadfence_block();
        __syncthreads();
        for (int e = tid; e < 128 * 768; e += nthreads) {
            const int i = e / 768, c = e % 768, g = c / 192; const bf16_t* wrow = WSB + (g * 128 + i) * 128; float acc = 0.f;
            for (int j = 0; j <= i; ++j) acc += bf2f(wrow[j]) * bf2f(VN[(size_t)(r0 + j) * 768 + c]);
            const float mix = acc + bsp[g * 128 + i];
            const size_t zr = (size_t)(r0 + i) * NIN;
            ASG[(size_t)(r0 + i) * DM + 256 + c] = f2bf(bf2f(ZB[zr + OU + c]) * mix * bf2f(ZB[zr + OGB + c]));
        }
        __syncthreads();
    }
}
DI void ph_gmlp_sample(const Params& P, int layer, int gw, int ngw, int lane) {
    unsigned char* ws = P.ws; const float* ZSF = (const float*)(ws + WS_SMP + SM_ZSF); bf16_t* SGS = (bf16_t*)(ws + WS_SMP + SM_SGS);
    const float* lg = P.v_norm_g + layer * 768; const float* lb = P.v_norm_b + layer * 768;
    for (int b = gw; b < DECB; b += ngw) {
        const float* z = ZSF + (size_t)b * NIN; float x[12]; float s = 0.f;
#pragma unroll
        for (int i = 0; i < 12; ++i) { x[i] = z[OGV + i * 64 + lane]; s += x[i]; }
        const float mean = wave_sum(s) * (1.0f / 768); float q = 0.f;
#pragma unroll
        for (int i = 0; i < 12; ++i) { x[i] -= mean; q += x[i] * x[i]; }
        const float rs = 1.0f / sqrtf(wave_sum(q) * (1.0f / 768) + EPS);
#pragma unroll
        for (int i = 0; i < 12; ++i) { const int c = i * 64 + lane, g = c / 192; const float vn = x[i] * rs * lg[c] + lb[c];
            P.out[O_VNS + ((size_t)layer * DECB + b) * 768 + c] = vn;
            const float mix = P.w_spatial[((size_t)layer * 4 + g) * 128 * 128] * vn + P.b_spatial[(layer * 4 + g) * 128];
            SGS[b * 768 + c] = f2bf(z[OU + c] * mix * z[OGB + c]); }
    }
}

DI void g2_wave_tile(const Params& P, int layer, bool smp, int rt, int ct, int lane) {
    unsigned char* ws = P.ws;
    const bf16_t* AGp = smp ? (const bf16_t*)(ws + WS_SMP + SM_AGS) : (const bf16_t*)(ws + WS_ASG);
    const bf16_t* SGp = smp ? (const bf16_t*)(ws + WS_SMP + SM_SGS) : (const bf16_t*)(ws + WS_ASG) + 256;
    bf16_t* MGp = smp ? (bf16_t*)(ws + WS_SMP + SM_MGS) : (bf16_t*)(ws + WS_MG);
    const bf16_t* W2 = (const bf16_t*)(ws + WS_W2) + (size_t)layer * DM * DM;
    f32x16 a = {}, b = {};
    a = wave_gemm32(AGp, smp ? 256 : DM, W2, DM, 256, rt * 32, ct * 32, lane, a);
    b = wave_gemm32(SGp, smp ? 768 : DM, W2 + 256, DM, 768, rt * 32, ct * 32, lane, b);
    const int hi = lane >> 5, col = ct * 32 + (lane & 31);
#pragma unroll
    for (int r = 0; r < 16; ++r) { const int row = rt * 32 + crow(r, hi); float ga, gb;
        if (smp) { const float* z = (const float*)(ws + WS_SMP + SM_ZSF) + (size_t)row * NIN + OGT; ga = z[col]; gb = z[DM + col]; }
        else { const bf16_t* z = (const bf16_t*)(ws + WS_ZB) + (size_t)row * NIN + OGT; ga = bf2f(z[col]); gb = bf2f(z[DM + col]); }
        MGp[(size_t)row * DM + col] = f2bf(ga * a[r] + gb * b[r]); }
}
DI void ph_g2_naive(const Params& P, int layer, int gw, int ngw, int lane) {
    constexpr int CT = DM / 32, RT = M / 32;
    for (int it = gw; it < RT * CT + CT; it += ngw) {
        if (it < RT * CT) g2_wave_tile(P, layer, false, it / CT, it % CT, lane); else g2_wave_tile(P, layer, true, 0, it - RT * CT, lane);
    }
}
DI void g3_wave_tile(const Params& P, int layer, bool smp, int rt, int ct, int lane) {
    unsigned char* ws = P.ws;
    const bf16_t* MGp = smp ? (const bf16_t*)(ws + WS_SMP + SM_MGS) : (const bf16_t*)(ws + WS_MG);
    float* Yp = smp ? (float*)(ws + WS_SMP + SM_YS) : (float*)(ws + WS_Y);
    f32x16 a = {};
    a = wave_gemm32(MGp, DM, (const bf16_t*)(ws + WS_WOUT) + (size_t)layer * DM * DM, DM, DM, rt * 32, ct * 32, lane, a);
    const int hi = lane >> 5, col = ct * 32 + (lane & 31);
#pragma unroll
    for (int r = 0; r < 16; ++r) Yp[(size_t)(rt * 32 + crow(r, hi)) * DM + col] = a[r];
}
DI void ph_g3_naive(const Params& P, int layer, int gw, int ngw, int lane) {
    constexpr int CT = DM / 32, RT = M / 32;
    for (int it = gw; it < RT * CT + CT; it += ngw) {
        if (it < RT * CT) g3_wave_tile(P, layer, false, it / CT, it % CT, lane); else g3_wave_tile(P, layer, true, 0, it - RT * CT, lane);
    }
}
DI void post_row(const float* xin, const float* y, const float* gpost, float* xout, bf16_t* xb, float* rstd_out, int lane) {
    const f32x4* yr = (const f32x4*)y + lane; const f32x4* xr = (const f32x4*)xin + lane; const f32x4* gr = (const f32x4*)gpost + lane;
    f32x4 v[4]; float ss = 0.f;
#pragma unroll
    for (int j = 0; j < 4; ++j) { v[j] = yr[64 * j]; ss += (v[j].x * v[j].x + v[j].y * v[j].y) + (v[j].z * v[j].z + v[j].w * v[j].w); }
    const float rs = 1.0f / sqrtf(wave_sum(ss) * (1.0f / DM) + EPS);
    float s2 = 0.f;
#pragma unroll
    for (int j = 0; j < 4; ++j) { const f32x4 x = xr[64 * j], g = gr[64 * j]; v[j] = x + v[j] * rs * g; s2 += (v[j].x * v[j].x + v[j].y * v[j].y) + (v[j].z * v[j].z + v[j].w * v[j].w); }
    s2 = wave_sum(s2);
    f32x4* xo = (f32x4*)xout + lane; unsigned long long* o8 = (unsigned long long*)xb + lane;
#pragma unroll
    for (int j = 0; j < 4; ++j) { xo[64 * j] = v[j]; o8[64 * j] = (unsigned long long)pk2(v[j].x, v[j].y) | ((unsigned long long)pk2(v[j].z, v[j].w) << 32); }
    if (lane == 0) *rstd_out = 1.0f / sqrtf(s2 * (1.0f / DM) + EPS);
}
DI void ph_post(const Params& P, int layer, int gw, int ngw, int lane) {
    unsigned char* ws = P.ws; const float* gpost = P.norm_post + layer * DM;
    for (int m = gw; m < M + DECB; m += ngw) {
        if (m < M) { const float* xin = (layer == 0) ? P.x_prompt + (size_t)m * DM : P.out + O_Y + (size_t)m * DM;
            post_row(xin, (const float*)(ws + WS_Y) + (size_t)m * DM, gpost, P.out + O_Y + (size_t)m * DM, (bf16_t*)(ws + WS_XB) + (size_t)m * DM, (float*)(ws + WS_RSTD) + m, lane); }
        else { const int b = m - M; const float* xin = (layer == 0) ? P.x_sample + (size_t)b * DM : P.out + O_YS + (size_t)b * DM;
            post_row(xin, (const float*)(ws + WS_SMP + SM_YS) + (size_t)b * DM, gpost, P.out + O_YS + (size_t)b * DM, (bf16_t*)(ws + WS_SMP + SM_XSB) + (size_t)b * DM, (float*)(ws + WS_SMP + SM_RSTD) + b, lane); }
    }
}

namespace pg8 {
#define PG8_LAS __attribute__((address_space(3)))
typedef unsigned short bf16_t;
typedef short bf16x8 __attribute__((ext_vector_type(8)));
typedef float f32x4 __attribute__((ext_vector_type(4)));
typedef unsigned u32x4 __attribute__((ext_vector_type(4)));
constexpr int BM = 256, BK = 64, HALF = 128, HTB = HALF * BK * 2  , STAGE_BYTES = 8 * HTB, NXCD = 8, WGM = 8;

__host__ __device__ __forceinline__ int lds_byte(int r, int c) { const int st = (r >> 4) * 2 + (c >> 5), rr = r & 15, cc = c & 31, ob = rr * 64 + cc * 2; return st * 1024 + (ob ^ (((ob >> 9) & 1) << 5)); }
__host__ __device__ __forceinline__ void stage_rc(int b, int& R, int& C) { const int st = b / 1024, sb = b % 1024, swz = sb ^ (((sb >> 9) & 1) << 5); R = (st >> 1) * 16 + swz / 64; C = (st & 1) * 32 + (swz % 64) / 2; }
__host__ __device__ __forceinline__ int perm32(int rho) { const int n = rho >> 4, i = rho & 15; return 8 * (i >> 2) + 4 * n + (i & 3); }

struct Unit { int pm, pn; };
struct Gemm { const bf16_t* A; const bf16_t* Bt; int M, N, K; };

struct StaticOrder {
    int nM, nN, nwg, G, c;
    __host__ __device__ void init(int M, int N, int G_, int c_) { nM = M / BM; nN = N / BM; nwg = nM * nN; G = G_; c = c_; }
    __host__ __device__ bool next(int i, Unit& u) const {
        const long L = (long)i * G + c; if (L >= nwg) return false;
        int wgid = (int)L; { const int q = nwg / NXCD, r = nwg % NXCD, xcd = wgid % NXCD, off = wgid / NXCD; wgid = (xcd < r ? xcd * (q + 1) : r * (q + 1) + (xcd - r) * q) + off; }
        const int nig = WGM * nN, gid = wgid / nig, fm = gid * WGM, gsz = (nM - fm) < WGM ? (nM - fm) : WGM;
        u.pm = fm + ((wgid % nig) % gsz); u.pn = (wgid % nig) / gsz; return true;
    }
    __device__ __forceinline__ void a_ready(const Unit&) const {}
    __device__ __forceinline__ void done(const Unit&) const {}
};

__device__ __forceinline__ unsigned cvt_pk_bf16(float lo, float hi) { unsigned r; asm volatile("v_cvt_pk_bf16_f32 %0, %1, %2" : "=v"(r) : "v"(lo), "v"(hi)); return r; }
typedef float f32x2 __attribute__((ext_vector_type(2)));
template <class Epi, class Sched, bool ALIGN_EPI = false, bool SP2 = false>
__device__ __forceinline__ void gemm_phase(PG8_LAS unsigned char* lds, const Gemm g, const Sched& S, const Epi& E) {
    int tid = threadIdx.x; asm volatile("" : "+v"(tid));
    const int wid = __builtin_amdgcn_readfirstlane(tid >> 6), lane = tid & 63, wr = wid >> 2, wc = wid & 3, fr = lane & 15, fq = lane >> 4;
    const int K = g.K, nt = K / BK;
    unsigned voffA[2], voffB[2];
#pragma unroll
    for (int i = 0; i < 2; ++i) { int R, C; stage_rc(tid * 16 + i * 8192, R, C); const int Rb = Epi::PERM ? ((R & ~31) + perm32(R & 31)) : R;
        voffA[i] = (unsigned)(R * K + C) * 2u; voffB[i] = (unsigned)(Rb * K + C) * 2u; }
    const size_t kstep = (size_t)(BK * 2);
    const size_t hstep = (size_t)HALF * K * 2;
    const size_t tstep = 2 * hstep;
    const unsigned ldsw = (unsigned)wid * 1024u;
    const int aoff = lds_byte(wr * 64 + fr, fq * 8), boff = lds_byte(wc * 32 + fr, fq * 8);
#define PG8_SA(b, h) (((b) * 2 + (h)) * HTB)
#define PG8_SB(b, h) ((4 + (b) * 2 + (h)) * HTB)
#define PG8_STAGE(bufoff, gbase, voff) do { _Pragma("unroll") for (int _i = 0; _i < 2; ++_i) \
        __builtin_amdgcn_global_load_lds((const unsigned*)((const char*)(gbase) + (voff)[_i]), (PG8_LAS unsigned*)(lds + (bufoff) + ldsw + _i * 8192), 16, 0, 0); } while (0)
#define PG8_LDA(dst, b, h) do { _Pragma("unroll") for (int m = 0; m < 4; ++m) _Pragma("unroll") for (int k = 0; k < 2; ++k) dst[m][k] = *(const PG8_LAS bf16x8*)(lds + PG8_SA(b, h) + aoff + m * 2048 + k * 1024); } while (0)
#define PG8_LDB(dst, b, h) do { _Pragma("unroll") for (int n = 0; n < 2; ++n) _Pragma("unroll") for (int k = 0; k < 2; ++k) dst[n][k] = *(const PG8_LAS bf16x8*)(lds + PG8_SB(b, h) + boff + n * 2048 + k * 1024); } while (0)
#define PG8_MMA(ai, bj, At, Bt) do { __builtin_amdgcn_s_setprio(1); _Pragma("unroll") for (int m = 0; m < 4; ++m) _Pragma("unroll") for (int n = 0; n < 2; ++n) _Pragma("unroll") for (int k = 0; k < 2; ++k) \
        acc[ai][bj][m][n] = __builtin_amdgcn_mfma_f32_16x16x32_bf16(Bt[n][k], At[m][k], acc[ai][bj][m][n], 0, 0, 0); __builtin_amdgcn_s_setprio(0); } while (0)
#define PG8_WAIT_V(n) asm volatile("s_waitcnt vmcnt(" #n ")" ::: "memory")
#define PG8_WAIT_L(n) asm volatile("s_waitcnt lgkmcnt(" #n ")" ::: "memory")
#define PG8_BAR __builtin_amdgcn_s_barrier()
#define PG8_SCHED __builtin_amdgcn_sched_barrier(0)
    Unit cur, nxt; int ui = 0;
    if (!S.next(0, cur)) return;
    f32x4 acc[2][2][4][2];
#pragma unroll
    for (int a = 0; a < 2; ++a)
#pragma unroll
        for (int b = 0; b < 2; ++b)
#pragma unroll
            for (int m = 0; m < 4; ++m)
#pragma unroll
                for (int n = 0; n < 2; ++n) acc[a][b][m][n] = (f32x4){0.f, 0.f, 0.f, 0.f};
    bf16x8 At[4][2], B0[2][2], B1[2][2];
    const char* cA = (const char*)g.A + (size_t)cur.pm * tstep; const char* cB = (const char*)g.Bt + (size_t)cur.pn * tstep;
    S.a_ready(cur);
    if constexpr (SP2) {
        PG8_STAGE(PG8_SB(0, 0), cB, voffB); PG8_STAGE(PG8_SB(0, 1), cB + hstep, voffB); PG8_STAGE(PG8_SA(0, 0), cA, voffA); PG8_STAGE(PG8_SA(0, 1), cA + hstep, voffA);
        if (wr == 1) PG8_BAR;
        PG8_WAIT_V(2); PG8_BAR;
        PG8_STAGE(PG8_SB(1, 0), cB + kstep, voffB); PG8_STAGE(PG8_SA(1, 0), cA + kstep, voffA); PG8_STAGE(PG8_SB(1, 1), cB + hstep + kstep, voffB);
        PG8_WAIT_V(6); PG8_BAR;
    } else {
        PG8_STAGE(PG8_SB(0, 0), cB, voffB); PG8_STAGE(PG8_SA(0, 0), cA, voffA); PG8_STAGE(PG8_SB(0, 1), cB + hstep, voffB); PG8_STAGE(PG8_SA(0, 1), cA + hstep, voffA);
        if (wr == 1) PG8_BAR;
        PG8_WAIT_V(4); PG8_BAR;
        PG8_STAGE(PG8_SB(1, 0), cB + kstep, voffB); PG8_STAGE(PG8_SA(1, 0), cA + kstep, voffA); PG8_STAGE(PG8_SB(1, 1), cB + hstep + kstep, voffB);
        PG8_WAIT_V(6); PG8_BAR;
    }
    for (;;) {
        const bool has_next = S.next(ui + 1, nxt);
        const char* nA = has_next ? (const char*)g.A + (size_t)nxt.pm * tstep : cA; const char* nB = has_next ? (const char*)g.Bt + (size_t)nxt.pn * tstep : cB;
        for (int t = 0; t < nt; t += 2) {
            if constexpr (Epi::HAS_MID) { if (t == Epi::MID_T) E.mid(acc, cur, wr, wc, fr, fq); }
            const bool last = (t == nt - 2);
            const char* a1 = cA + (size_t)(t + 1) * kstep;
            const char* a2 = last ? nA : cA + (size_t)(t + 2) * kstep; const char* b2 = last ? nB : cB + (size_t)(t + 2) * kstep;
            const char* a3 = a2 + kstep; const char* b3 = b2 + kstep;
            if (last && has_next) S.a_ready(nxt);
            if constexpr (SP2) {
            PG8_LDB(B0, 0, 0); PG8_LDB(B1, 0, 1); PG8_SCHED; PG8_LDA(At, 0, 0); PG8_STAGE(PG8_SA(1, 1), a1 + hstep, voffA);
            PG8_WAIT_V(8); PG8_WAIT_L(0); PG8_BAR; PG8_MMA(0, 0, At, B0); PG8_MMA(0, 1, At, B1); PG8_BAR; PG8_SCHED;
            PG8_LDA(At, 0, 1); PG8_STAGE(PG8_SB(0, 0), b2, voffB); PG8_STAGE(PG8_SB(0, 1), b2 + hstep, voffB); PG8_STAGE(PG8_SA(0, 0), a2, voffA);
            PG8_WAIT_V(8); PG8_WAIT_L(0); PG8_BAR; PG8_MMA(1, 0, At, B0); PG8_MMA(1, 1, At, B1); PG8_BAR; PG8_SCHED;
            PG8_LDB(B0, 1, 0); PG8_LDB(B1, 1, 1); PG8_SCHED; PG8_LDA(At, 1, 0); PG8_STAGE(PG8_SA(0, 1), a2 + hstep, voffA);
            PG8_WAIT_V(8); PG8_WAIT_L(0); PG8_BAR; PG8_MMA(0, 0, At, B0); PG8_MMA(0, 1, At, B1); PG8_BAR; PG8_SCHED;
            PG8_LDA(At, 1, 1); PG8_STAGE(PG8_SB(1, 0), b3, voffB); PG8_STAGE(PG8_SB(1, 1), b3 + hstep, voffB); PG8_STAGE(PG8_SA(1, 0), a3, voffA);
            PG8_WAIT_V(8); PG8_WAIT_L(0); PG8_BAR; PG8_MMA(1, 0, At, B0); PG8_MMA(1, 1, At, B1); PG8_BAR; PG8_SCHED;
            } else {
            PG8_LDB(B0, 0, 0); PG8_SCHED; PG8_LDA(At, 0, 0); PG8_STAGE(PG8_SA(1, 1), a1 + hstep, voffA);
            PG8_WAIT_L(8); PG8_BAR; PG8_WAIT_L(0); PG8_MMA(0, 0, At, B0); PG8_BAR; PG8_SCHED;
            PG8_LDB(B1, 0, 1); PG8_STAGE(PG8_SB(0, 0), b2, voffB);
            PG8_BAR; PG8_WAIT_L(0); PG8_MMA(0, 1, At, B1); PG8_BAR;
            PG8_LDA(At, 0, 1); PG8_STAGE(PG8_SA(0, 0), a2, voffA);
            PG8_BAR; PG8_WAIT_L(0); PG8_MMA(1, 0, At, B0); PG8_BAR; PG8_SCHED;
            PG8_STAGE(PG8_SB(0, 1), b2 + hstep, voffB);
            PG8_WAIT_V(6); PG8_BAR; PG8_MMA(1, 1, At, B1); PG8_BAR;
            PG8_LDB(B0, 1, 0); PG8_SCHED; PG8_LDA(At, 1, 0); PG8_STAGE(PG8_SA(0, 1), a2 + hstep, voffA);
            PG8_WAIT_L(8); PG8_BAR; PG8_WAIT_L(0); PG8_MMA(0, 0, At, B0); PG8_BAR; PG8_SCHED;
            PG8_LDB(B1, 1, 1); PG8_STAGE(PG8_SB(1, 0), b3, voffB);
            PG8_BAR; PG8_WAIT_L(0); PG8_MMA(0, 1, At, B1); PG8_BAR;
            PG8_LDA(At, 1, 1); PG8_STAGE(PG8_SA(1, 0), a3, voffA);
            PG8_BAR; PG8_WAIT_L(0); PG8_MMA(1, 0, At, B0); PG8_BAR; PG8_SCHED;
            PG8_STAGE(PG8_SB(1, 1), b3 + hstep, voffB);
            PG8_WAIT_V(6); PG8_BAR; PG8_MMA(1, 1, At, B1); PG8_BAR;
            }
        }
        if constexpr (ALIGN_EPI) { if (wr == 0) PG8_BAR; }
        if constexpr (!Epi::AFTER_DRAIN) { E(acc, cur, wr, wc, fr, fq); S.done(cur); }
        if (!has_next) break;
#pragma unroll
        for (int a = 0; a < 2; ++a)
#pragma unroll
            for (int b = 0; b < 2; ++b)
#pragma unroll
                for (int m = 0; m < 4; ++m)
#pragma unroll
                    for (int n = 0; n < 2; ++n) acc[a][b][m][n] = (f32x4){0.f, 0.f, 0.f, 0.f};
        cur = nxt; cA = nA; cB = nB; ++ui;
        if constexpr (ALIGN_EPI) { if (wr == 1) PG8_BAR; }
    }
    PG8_WAIT_V(0);
    if constexpr (!ALIGN_EPI) { if (wr == 0) PG8_BAR; }
    PG8_BAR;
    if constexpr (Epi::AFTER_DRAIN) { E.fused(acc, cur, wr, wc, fr, fq, lds, wid, lane); S.done(cur); }
#undef PG8_SA
#undef PG8_SB
#undef PG8_STAGE
#undef PG8_LDA
#undef PG8_LDB
#undef PG8_MMA
#undef PG8_WAIT_V
#undef PG8_WAIT_L
#undef PG8_BAR
#undef PG8_SCHED
}
}

DI float fsig(float x) { return __builtin_amdgcn_rcpf(1.0f + __builtin_amdgcn_exp2f(-1.4426950408889634f * x)); }
DI float fsilu(float x) { return x * fsig(x); }
DI float fgelu(float x) { return x * fsig(1.5957691216057308f * (x + 0.044715f * x * x * x)); }
typedef float f32x2_t __attribute__((ext_vector_type(2))); typedef __bf16 bf16x2_t __attribute__((ext_vector_type(2)));
DI unsigned cvtpk(float lo, float hi) { f32x2_t v = {lo, hi}; bf16x2_t b = __builtin_convertvector(v, bf16x2_t); return __builtin_bit_cast(unsigned, b); }
DI u32x4 pack8(const f32x4& a, const f32x4& b) { u32x4 w; w.x = cvtpk(a[0], a[1]); w.y = cvtpk(a[2], a[3]); w.z = cvtpk(b[0], b[1]); w.w = cvtpk(b[2], b[3]); return w; }
DI f32x4 shx16(const f32x4& v) { f32x4 r; r[0] = __shfl_xor(v[0], 16); r[1] = __shfl_xor(v[1], 16); r[2] = __shfl_xor(v[2], 16); r[3] = __shfl_xor(v[3], 16); return r; }

struct EpiG1 {
    static constexpr bool PERM = true, AFTER_DRAIN = false, HAS_MID = false; static constexpr int MID_T = -1;
    bf16_t* ZB; const float* rstd; const float* rope; const float* bm; float* out; int layer;
    DI void mid(f32x4 (&)[2][2][4][2], const pg8::Unit&, int, int, int, int) const {}
    template <int KIND>
    DI void act_rows(const f32x4 (&acc)[2][2][4][2], int pm, int pn, int wr, int cw, int fr) const {
        f32x4 bv[2][2];
#pragma unroll
        for (int bj = 0; bj < 2; ++bj)
#pragma unroll
            for (int n = 0; n < 2; ++n) bv[bj][n] = (KIND == 2) ? *(const f32x4*)(bm + (pn * 256 - OGT) + bj * 128 + cw + 4 * n) : (f32x4){0.f, 0.f, 0.f, 0.f};
#pragma unroll
        for (int ai = 0; ai < 2; ++ai)
#pragma unroll
            for (int m = 0; m < 4; ++m) { const int row = pm * 256 + ai * 128 + wr * 64 + m * 16 + fr; const float rs = rstd[row];
                bf16_t* rowp = ZB + (size_t)row * NIN + pn * 256 + cw;
#pragma unroll
                for (int bj = 0; bj < 2; ++bj) { f32x4 v0 = acc[ai][bj][m][0] * rs + bv[bj][0], v1 = acc[ai][bj][m][1] * rs + bv[bj][1];
#pragma unroll
                    for (int e = 0; e < 4; ++e) { if (KIND == 0) { v0[e] = fsilu(v0[e]); v1[e] = fsilu(v1[e]); } else if (KIND == 1) { v0[e] = fgelu(v0[e]); v1[e] = fgelu(v1[e]); } else { v0[e] = fsig(v0[e]); v1[e] = fsig(v1[e]); } }
                    *(u32x4*)(rowp + bj * 128) = pack8(v0, v1); }
                if (m & 1) asm volatile("" ::: "memory"); }
    }
    DI void operator()(const f32x4 (&acc)[2][2][4][2], const pg8::Unit& u, int wr, int wc, int fr, int fq) const {
        const int pn = u.pn, pm = u.pm, cw = wc * 32 + 8 * fq;
        if (pn < 9) {
            const bool is_q = pn < 3, is_v = pn >= 6, do_rope = !is_v && ((wc & 1) == 0);
            const int g = is_q ? 0 : (pn - 3) % 3, kv = is_v ? 1 : 0, keep = 128 << (2 * g), b = pm >> 3;
            const size_t obase = ((g == 0) ? O_KV128P : (g == 1) ? O_KV512P : O_KV2048P) + ((size_t)layer * BATCH + b) * keep * 512 + kv * 256 + cw;
            const float sgn = (fq == 0) ? -1.0f : 1.0f;
#pragma unroll
            for (int ai = 0; ai < 2; ++ai)
#pragma unroll
                for (int m = 0; m < 4; ++m) { const int row = pm * 256 + ai * 128 + wr * 64 + m * 16 + fr, t = row & (SEQ - 1); const float rs = rstd[row];
                    f32x4 c0, c1, s0, s1;
                    if (do_rope) { c0 = *(const f32x4*)(rope + t * 8); c1 = *(const f32x4*)(rope + t * 8 + 4); s0 = *(const f32x4*)(rope + 2049 * 8 + t * 8) * sgn; s1 = *(const f32x4*)(rope + 2049 * 8 + t * 8 + 4) * sgn; }
                    bf16_t* rowp = ZB + (size_t)row * NIN + pn * 256 + cw; const int j = t - (SEQ - keep);
#pragma unroll
                    for (int bj = 0; bj < 2; ++bj) { f32x4 v0 = acc[ai][bj][m][0] * rs, v1 = acc[ai][bj][m][1] * rs;
                        if (do_rope) { const f32x4 p0 = shx16(v0), p1 = shx16(v1); const f32x4 r0 = v0 * c0 + p0 * s0, r1 = v1 * c1 + p1 * s1; if (fq < 2) { v0 = r0; v1 = r1; } }
                        if (!is_q && j >= 0) { float* op = out + obase + (size_t)j * 512 + bj * 128; *(f32x4*)op = v0; *(f32x4*)(op + 4) = v1; }
                        if (is_q) { v0 = v0 * C2; v1 = v1 * C2; }
                        *(u32x4*)(rowp + bj * 128) = pack8(v0, v1); }
                    if (m & 1) asm volatile("" ::: "memory"); }
        } else if (pn == 9 || (pn >= 16 && pn < 19)) act_rows<0>(acc, pm, pn, wr, cw, fr);
        else if (pn < 16) act_rows<1>(acc, pm, pn, wr, cw, fr);
        else act_rows<2>(acc, pm, pn, wr, cw, fr);
    }
};
struct EpiG2 {
    static constexpr bool PERM = true, AFTER_DRAIN = false, HAS_MID = true; static constexpr int MID_T = 4;
    const bf16_t* ZB; bf16_t* MG;
    DI void mid(f32x4 (&acc)[2][2][4][2], const pg8::Unit& u, int wr, int wc, int fr, int fq) const {
        const int cw = wc * 32 + 8 * fq;
#pragma unroll
        for (int ai = 0; ai < 2; ++ai)
#pragma unroll
            for (int m = 0; m < 4; ++m) { const int row = u.pm * 256 + ai * 128 + wr * 64 + m * 16 + fr; const bf16_t* gp = ZB + (size_t)row * NIN + OGT + u.pn * 256 + cw;
#pragma unroll
                for (int bj = 0; bj < 2; ++bj) { const bf16x8 ga = *(const bf16x8*)(gp + bj * 128), gb = *(const bf16x8*)(gp + DM + bj * 128);
#pragma unroll
                    for (int e = 0; e < 4; ++e) { acc[ai][bj][m][0][e] *= bfs2f(ga[e]) * __builtin_amdgcn_rcpf(fmaxf(bfs2f(gb[e]), 1e-30f)); acc[ai][bj][m][1][e] *= bfs2f(ga[4 + e]) * __builtin_amdgcn_rcpf(fmaxf(bfs2f(gb[4 + e]), 1e-30f)); } }
                if (m & 1) asm volatile("" ::: "memory"); }
    }
    DI void operator()(const f32x4 (&acc)[2][2][4][2], const pg8::Unit& u, int wr, int wc, int fr, int fq) const {
        const int cw = wc * 32 + 8 * fq;
#pragma unroll
        for (int ai = 0; ai < 2; ++ai)
#pragma unroll
            for (int m = 0; m < 4; ++m) { const int row = u.pm * 256 + ai * 128 + wr * 64 + m * 16 + fr; const bf16_t* gp = ZB + (size_t)row * NIN + OGT + DM + u.pn * 256 + cw;
                bf16_t* rowp = MG + (size_t)row * DM + u.pn * 256 + cw;
#pragma unroll
                for (int bj = 0; bj < 2; ++bj) { const bf16x8 gb = *(const bf16x8*)(gp + bj * 128); f32x4 v0 = acc[ai][bj][m][0], v1 = acc[ai][bj][m][1];
#pragma unroll
                    for (int e = 0; e < 4; ++e) { v0[e] *= fmaxf(bfs2f(gb[e]), 1e-30f); v1[e] *= fmaxf(bfs2f(gb[4 + e]), 1e-30f); }
                    *(u32x4*)(rowp + bj * 128) = pack8(v0, v1); }
                if (m & 1) asm volatile("" ::: "memory"); }
    }
};
struct EpiG3 {
    static constexpr bool PERM = true, AFTER_DRAIN = false, HAS_MID = false; static constexpr int MID_T = -1;
    float* Y;
    DI void mid(f32x4 (&)[2][2][4][2], const pg8::Unit&, int, int, int, int) const {}
    DI void operator()(const f32x4 (&acc)[2][2][4][2], const pg8::Unit& u, int wr, int wc, int fr, int fq) const {
        const int cw = wc * 32 + 8 * fq;
#pragma unroll
        for (int ai = 0; ai < 2; ++ai)
#pragma unroll
            for (int m = 0; m < 4; ++m) { float* rowp = Y + (size_t)(u.pm * 256 + ai * 128 + wr * 64 + m * 16 + fr) * DM + u.pn * 256 + cw;
#pragma unroll
                for (int bj = 0; bj < 2; ++bj) { *(f32x4*)(rowp + bj * 128) = acc[ai][bj][m][0]; *(f32x4*)(rowp + bj * 128 + 4) = acc[ai][bj][m][1]; } }
    }
};


typedef short s16x4 __attribute__((ext_vector_type(4)));
typedef short v4i16_t __attribute__((ext_vector_type(4)));
constexpr int VT_PITCH = 192, VT_BYTES = 32 * VT_PITCH;
DI s16x4 vtr(const LAS unsigned char* p) { return __builtin_bit_cast(s16x4, __builtin_amdgcn_ds_read_tr16_b64_v4i16((LAS v4i16_t*)p)); }
DI void attn_item(const Params& P, int item, LAS unsigned char* vbuf, int lane) {
    const bf16_t* ZB = (const bf16_t*)(P.ws + WS_ZB); bf16_t* ASG = (bf16_t*)(P.ws + WS_ASG);
    const int qblk = item & 3, r = (item >> 2) & 15, hs = (item >> 6) & 3, b = item >> 8;
    const int i = lane & 31, hi = lane >> 5;
    const int rowb = b * SEQ, tq = r + 16 * (32 * qblk + i);
    float m = -1e30f, l = 0.f; f32x16 o0 = {}, o1 = {};
    const int vrow = lane >> 3, vch = lane & 7;
    const int li = lane & 15;
    LAS unsigned char* trb = vbuf + (4 * hi + (li >> 2)) * VT_PITCH + ((lane >> 4) & 1) * 32 + (li & 3) * 8;
    int par = 0;
#pragma unroll 1
    for (int g = 0; g < 3; ++g) {
        const int lg = 2 * g, d = 1 << lg, c = 16 >> lg, n = SEQ >> lg, head = g * 4 + hs;
        const int rho = r & (d - 1), a = (r >> lg) + c * 32 * qblk;
        const int s_lo = (a - 128) > 0 ? (a - 128) : 0, s_hi = a + 31 * c, nt = ((s_hi - s_lo) >> 5) + 1;
        const bf16_t* qp = ZB + (size_t)(rowb + tq) * NIN + OQ + head * 64 + 8 * hi;
        bf16x8 qf[4];
#pragma unroll
        for (int ks = 0; ks < 4; ++ks) qf[ks] = *(const bf16x8*)(qp + 16 * ks);
        const bf16_t* kbase = ZB + (size_t)rowb * NIN + OKK + head * 64 + 8 * hi;
        const bf16_t* vbase = ZB + (size_t)rowb * NIN + OV + head * 64 + 8 * vch;
        const int sq = a + c * i;
        bf16x8 kf[4]; u32x4 vs[4];
        {   int sk = s_lo + i; sk = sk < n - 1 ? sk : n - 1; const bf16_t* kp = kbase + (size_t)(rho + (sk << lg)) * NIN;
#pragma unroll
            for (int ks = 0; ks < 4; ++ks) kf[ks] = *(const bf16x8*)(kp + 16 * ks);
#pragma unroll
            for (int q = 0; q < 4; ++q) { int sv = s_lo + vrow + 8 * q; sv = sv < n - 1 ? sv : n - 1; vs[q] = *(const u32x4*)(vbase + (size_t)(rho + (sv << lg)) * NIN); } }
#pragma unroll 1
        for (int kt = 0; kt < nt; ++kt) {
            const int k0 = s_lo + 32 * kt;
            LAS unsigned char* vb = vbuf + par * VT_BYTES; LAS unsigned char* tb = trb + par * VT_BYTES; par ^= 1;
#pragma unroll
            for (int q = 0; q < 4; ++q) *(LAS u32x4*)(vb + (vrow + 8 * q) * VT_PITCH + vch * 16) = vs[q];
            f32x16 st = {};
#pragma unroll
            for (int ks = 0; ks < 4; ++ks) st = __builtin_amdgcn_mfma_f32_32x32x16_bf16(kf[ks], qf[ks], st, 0, 0, 0);
            {
                int sk = k0 + 32 + i; sk = sk < n - 1 ? sk : n - 1; const bf16_t* kp = kbase + (size_t)(rho + (sk << lg)) * NIN;
#pragma unroll
                for (int ks = 0; ks < 4; ++ks) kf[ks] = *(const bf16x8*)(kp + 16 * ks);
#pragma unroll
                for (int q = 0; q < 4; ++q) { int sv = k0 + 32 + vrow + 8 * q; sv = sv < n - 1 ? sv : n - 1; vs[q] = *(const u32x4*)(vbase + (size_t)(rho + (sv << lg)) * NIN); } }
            const int bi = sq - k0 - 4 * hi;
            float tmax = -INFINITY;
#pragma unroll
            for (int e = 0; e < 16; ++e) { const int cr = (e & 3) + 8 * (e >> 2); const bool valid = (unsigned)(bi - cr) <= 128u; st[e] = valid ? st[e] : -INFINITY; tmax = fmaxf(tmax, st[e]); }
            tmax = fmaxf(tmax, __shfl_xor(tmax, 32));
            if (__any(tmax > m)) { const float mn = fmaxf(m, tmax), al = __builtin_amdgcn_exp2f(m - mn); l *= al; o0 = o0 * al; o1 = o1 * al; m = mn; }
            float ps = 0.f;
#pragma unroll
            for (int e = 0; e < 16; ++e) { st[e] = __builtin_amdgcn_exp2f(st[e] - m); ps += st[e]; }
            l += ps;
            u32x4 pw0, pw1;
            pw0.x = cvtpk(st[0], st[1]); pw0.y = cvtpk(st[2], st[3]); pw0.z = cvtpk(st[4], st[5]); pw0.w = cvtpk(st[6], st[7]);
            pw1.x = cvtpk(st[8], st[9]); pw1.y = cvtpk(st[10], st[11]); pw1.z = cvtpk(st[12], st[13]); pw1.w = cvtpk(st[14], st[15]);
            const bf16x8 pf0 = __builtin_bit_cast(bf16x8, pw0), pf1 = __builtin_bit_cast(bf16x8, pw1);
#pragma unroll
            for (int sidx = 0; sidx < 2; ++sidx) {
#pragma unroll
                for (int db = 0; db < 2; ++db) {
                    const s16x4 lo = vtr(tb + sidx * 16 * VT_PITCH + db * 64), hi4 = vtr(tb + sidx * 16 * VT_PITCH + 8 * VT_PITCH + db * 64);
                    const bf16x8 vt = (bf16x8){lo[0], lo[1], lo[2], lo[3], hi4[0], hi4[1], hi4[2], hi4[3]};
                    if (db == 0) o0 = __builtin_amdgcn_mfma_f32_32x32x16_bf16(vt, sidx ? pf1 : pf0, o0, 0, 0, 0);
                    else         o1 = __builtin_amdgcn_mfma_f32_32x32x16_bf16(vt, sidx ? pf1 : pf0, o1, 0, 0, 0);
                } }
        }
    }
    l += __shfl_xor(l, 32);
    const float inv = 1.0f / l;
    const size_t orow = (size_t)(rowb + tq);
    typedef unsigned u32x2 __attribute__((ext_vector_type(2)));
#pragma unroll
    for (int db = 0; db < 2; ++db)
#pragma unroll
        for (int q = 0; q < 4; ++q) { const int d0 = db * 32 + 8 * q + 4 * hi;
            const u32x2 gw2 = *(const u32x2*)(ZB + orow * NIN + OGA + hs * 64 + d0);
            const float g0 = __uint_as_float(gw2.x << 16), g1 = __uint_as_float(gw2.x & 0xffff0000u), g2 = __uint_as_float(gw2.y << 16), g3 = __uint_as_float(gw2.y & 0xffff0000u);
            const f32x16& oo = db ? o1 : o0;
            u32x2 w; w.x = cvtpk(oo[4 * q] * inv * g0, oo[4 * q + 1] * inv * g1); w.y = cvtpk(oo[4 * q + 2] * inv * g2, oo[4 * q + 3] * inv * g3);
            *(u32x2*)(ASG + orow * DM + hs * 64 + d0) = w; }
}
DI void ph_attn_fast(const Params& P, LAS unsigned char* lds, int gw, int ngw, int wave, int lane) {
    LAS unsigned char* vbuf = lds + wave * (2 * VT_BYTES);
    for (int item = gw; item < BATCH * 4 * 16 * 4; item += ngw) attn_item(P, item, vbuf, lane);
}


constexpr int VN_PITCH = 448, VN_BYTES = 128 * VN_PITCH, GM_STAT_OFF = VN_BYTES;
DI void gmlp_unit(const Params& P, int layer, int unit, LAS unsigned char* lds, int tid) {
    const bf16_t* ZB = (const bf16_t*)(P.ws + WS_ZB); bf16_t* ASG = (bf16_t*)(P.ws + WS_ASG);
    const bf16_t* WSB = (const bf16_t*)(P.ws + WS_WSB) + (size_t)layer * 4 * 128 * 128;
    const float* lg = P.v_norm_g + layer * 768; const float* lb = P.v_norm_b + layer * 768; const float* bsp = P.b_spatial + layer * 4 * 128;
    const int ch = unit >> 1, gp = unit & 1, r0 = ch * 128;
    const int lane = tid & 63, wave = __builtin_amdgcn_readfirstlane(tid >> 6), hi = lane >> 5, i32 = lane & 31, li = lane & 15;
    LAS float* stat = (LAS float*)(lds + GM_STAT_OFF);
    typedef unsigned u32x2 __attribute__((ext_vector_type(2)));
    for (int rr = 0; rr < 16; ++rr) {
        const int row = wave * 16 + rr; const bf16_t* gp_ = ZB + (size_t)(r0 + row) * NIN + OGV + lane * 4;
        float x[12]; float sum = 0.f;
#pragma unroll
        for (int k = 0; k < 3; ++k) { const u32x2 w = *(const u32x2*)(gp_ + 256 * k);
            x[4 * k] = __uint_as_float(w.x << 16); x[4 * k + 1] = __uint_as_float(w.x & 0xffff0000u); x[4 * k + 2] = __uint_as_float(w.y << 16); x[4 * k + 3] = __uint_as_float(w.y & 0xffff0000u);
            sum += (x[4 * k] + x[4 * k + 1]) + (x[4 * k + 2] + x[4 * k + 3]); }
        const float mean = wave_sum(sum) * (1.0f / 768); float q = 0.f;
#pragma unroll
        for (int k = 0; k < 12; ++k) { const float dlt = x[k] - mean; q += dlt * dlt; }
        const float rs = 1.0f / sqrtf(wave_sum(q) * (1.0f / 768) + EPS);
        if (lane == 0) { stat[2 * row] = mean; stat[2 * row + 1] = rs; }
    }
    __syncthreads();
#pragma unroll 1
    for (int gi = 0; gi < 2; ++gi) {
        const int g = 2 * gp + gi;
        for (int idx = tid; idx < 128 * 24; idx += 512) {
            const int row = idx / 24, cc = idx - row * 24, ct = g * 192 + cc * 8;
            const u32x4 w = *(const u32x4*)(ZB + (size_t)(r0 + row) * NIN + OGV + ct);
            const float mean = stat[2 * row], rs = stat[2 * row + 1];
            const f32x4 g0 = *(const f32x4*)(lg + ct), g1 = *(const f32x4*)(lg + ct + 4), b0 = *(const f32x4*)(lb + ct), b1 = *(const f32x4*)(lb + ct + 4);
            f32x4 v0, v1;
            v0[0] = __uint_as_float(w.x << 16); v0[1] = __uint_as_float(w.x & 0xffff0000u); v0[2] = __uint_as_float(w.y << 16); v0[3] = __uint_as_float(w.y & 0xffff0000u);
            v1[0] = __uint_as_float(w.z << 16); v1[1] = __uint_as_float(w.z & 0xffff0000u); v1[2] = __uint_as_float(w.w << 16); v1[3] = __uint_as_float(w.w & 0xffff0000u);
            v0 = (v0 - mean) * rs * g0 + b0; v1 = (v1 - mean) * rs * g1 + b1;
            *(LAS u32x4*)(lds + row * VN_PITCH + cc * 16) = pack8(v0, v1);
        }
        __syncthreads();
#pragma unroll 1
        for (int tt = 0; tt < 3; ++tt) {
            const int tau = wave + 8 * tt; const int ib = 3 - tau / 6, cb = tau % 6;
            f32x16 acc = {};
            const bf16_t* wrow = WSB + ((size_t)g * 128 + ib * 32 + i32) * 128 + 8 * hi;
            const LAS unsigned char* trb = lds + (8 * hi + (li >> 2)) * VN_PITCH + (cb * 32 + ((lane >> 4) & 1) * 16 + (li & 3) * 4) * 2;
            for (int ks = 0; ks <= 2 * ib + 1; ++ks) {
                const s16x4 lo = vtr(trb + ks * 16 * VN_PITCH), hi4 = vtr(trb + ks * 16 * VN_PITCH + 4 * VN_PITCH);
                const bf16x8 a = (bf16x8){lo[0], lo[1], lo[2], lo[3], hi4[0], hi4[1], hi4[2], hi4[3]};
                const bf16x8 bfr = *(const bf16x8*)(wrow + 16 * ks);
                acc = __builtin_amdgcn_mfma_f32_32x32x16_bf16(a, bfr, acc, 0, 0, 0);
            }
            const int irow = ib * 32 + i32; const float bias = bsp[g * 128 + irow]; const size_t zr = (size_t)(r0 + irow) * NIN;
#pragma unroll
            for (int q = 0; q < 4; ++q) { const int ct = g * 192 + cb * 32 + 8 * q + 4 * hi;
                const u32x2 uw = *(const u32x2*)(ZB + zr + OU + ct), gw2 = *(const u32x2*)(ZB + zr + OGB + ct);
                const float o0 = __uint_as_float(uw.x << 16) * (acc[4 * q] + bias) * __uint_as_float(gw2.x << 16);
                const float o1 = __uint_as_float(uw.x & 0xffff0000u) * (acc[4 * q + 1] + bias) * __uint_as_float(gw2.x & 0xffff0000u);
                const float o2 = __uint_as_float(uw.y << 16) * (acc[4 * q + 2] + bias) * __uint_as_float(gw2.y << 16);
                const float o3 = __uint_as_float(uw.y & 0xffff0000u) * (acc[4 * q + 3] + bias) * __uint_as_float(gw2.y & 0xffff0000u);
                u32x2 w; w.x = cvtpk(o0, o1); w.y = cvtpk(o2, o3);
                *(u32x2*)(ASG + (size_t)(r0 + irow) * DM + 256 + ct) = w; }
        }
        __syncthreads();
    }
}
DI void ph_gmlp_fast(const Params& P, int layer, LAS unsigned char* lds, int wg, int nwg, int tid) {
    for (int unit = wg; unit < (M / 128) * 2; unit += nwg) gmlp_unit(P, layer, unit, lds, tid);
}

#define XB_TMO      128
#define XB_XCNT(j)  (256  + 64 * (j))
#define XB_XSUB(j)  (1280 + 64 * (j))
#define XB_XGEN(j)  (2304 + 64 * (j))
#define XB_TOP      3328
#define XB_TOPGEN   3392
#define XCD_BAR_WORDS 3456
#define XB_SPIN_CAP (1u << 18)
__device__ __forceinline__ unsigned xb_ld(unsigned* p)              { return __hip_atomic_load(p, __ATOMIC_RELAXED, __HIP_MEMORY_SCOPE_AGENT); }
__device__ __forceinline__ unsigned xb_add(unsigned* p, unsigned v) { return __hip_atomic_fetch_add(p, v, __ATOMIC_RELAXED, __HIP_MEMORY_SCOPE_AGENT); }
__device__ __forceinline__ unsigned xb_xcc_id() { return (unsigned)__builtin_amdgcn_s_getreg((3 << 11) | 20) & 0xFu; }
#define XB_SPIN(cond, bar) do { unsigned _sp = 0; while (cond) { __builtin_amdgcn_s_sleep(1); \
    if ((++_sp & 255u) == 0u) { if (xb_ld(&(bar)[XB_TMO])) break; if (_sp > XB_SPIN_CAP) { atomicAdd(&(bar)[XB_TMO], 1u); break; } } } } while (0)
struct XcdBarrier { unsigned* bar; unsigned x; volatile LAS unsigned* st; };
__device__ __forceinline__ XcdBarrier xcd_barrier_post(unsigned* bar, volatile LAS unsigned* st) {
    XcdBarrier b; b.bar = bar; b.x = xb_xcc_id(); b.st = st;
    if (threadIdx.x == 0) { (void)xb_add(&bar[XB_XCNT(b.x)], 1u); st[2] = b.x; }
    return b;
}
__device__ __forceinline__ void xcd_barrier_complete(unsigned* bar, unsigned x, unsigned& nloc, unsigned& nx) {
    const unsigned G = gridDim.x * gridDim.y * gridDim.z;
    unsigned sum, cnt, mine, sp = 0u;
    for (;;) {
        sum = 0u; cnt = 0u; mine = 0u;
#pragma unroll
        for (unsigned j = 0; j < 16; ++j) { const unsigned c = xb_ld(&bar[XB_XCNT(j)]); sum += c; cnt += (c > 0u) ? 1u : 0u; mine = (j == x) ? c : mine; }
        if (sum == G) break;
        __builtin_amdgcn_s_sleep(1);
        if ((++sp & 255u) == 0u) { if (xb_ld(&bar[XB_TMO])) break; if (sp > XB_SPIN_CAP) { atomicAdd(&bar[XB_TMO], 1u); break; } }
    }
    nloc = mine > 0u ? mine : 1u; nx = cnt > 0u ? cnt : 1u;
}
__device__ __forceinline__ void xcd_barrier(const XcdBarrier& b) {
    asm volatile("s_waitcnt vmcnt(0)" ::: "memory");
    __syncthreads();
    if (threadIdx.x == 0) {
        unsigned* bar = b.bar;
        __builtin_amdgcn_s_waitcnt(0);
        unsigned nloc = b.st[0], nx = b.st[1]; const unsigned bx = b.st[2];
        if (nloc == 0u) { xcd_barrier_complete(bar, bx, nloc, nx); b.st[0] = nloc; b.st[1] = nx; }
        const unsigned old = xb_add(&bar[XB_XSUB(bx)], 1u);
        const unsigned gen = old / nloc;
        if (old + 1u == (gen + 1u) * nloc) {
            __builtin_amdgcn_fence(__ATOMIC_RELEASE, "agent");
            asm volatile("s_waitcnt vmcnt(0)" ::: "memory");
            const unsigned og = xb_add(&bar[XB_TOP], 1u);
            const unsigned tg = og / nx;
            if (og + 1u == (tg + 1u) * nx) xb_add(&bar[XB_TOPGEN], 1u);
            else XB_SPIN(xb_ld(&bar[XB_TOPGEN]) == tg, bar);
            __builtin_amdgcn_fence(__ATOMIC_ACQUIRE, "agent");
            xb_add(&bar[XB_XGEN(bx)], 1u);
            asm volatile("s_waitcnt vmcnt(0)" ::: "memory");
        } else {
            XB_SPIN(xb_ld(&bar[XB_XGEN(bx)]) == gen, bar);
            __builtin_amdgcn_fence(__ATOMIC_ACQUIRE, "agent");
            asm volatile("s_waitcnt vmcnt(0)" ::: "memory");
        }
    }
    __syncthreads();
}

#ifndef FAST_ATTN
#define FAST_ATTN 1
#endif
#ifndef FAST_GMLP
#define FAST_GMLP 1
#endif
constexpr int NT = 512;
constexpr int RING_BYTES = 131072, LDSCTL_OFF = RING_BYTES, MISC_OFF = LDSCTL_OFF + 320, LDS_BYTES = 147456;
constexpr int CW_BAR = 4096;
constexpr size_t CTL_ZERO_BYTES = 65536;
__global__ void __launch_bounds__(NT, 2) mega_kernel(Params P) {
    extern __shared__ __attribute__((aligned(16))) unsigned char lds[];
    const int tid = threadIdx.x, lane = tid & 63, wave = __builtin_amdgcn_readfirstlane(tid >> 6);
    const int G = gridDim.x;
    const int vcu = (G % 8 == 0) ? ((int)blockIdx.x % 8) * (G / 8) + (int)blockIdx.x / 8 : (int)blockIdx.x;
    const int gw = vcu * (NT / 64) + wave, ngw = G * (NT / 64);
    LAS unsigned char* l3 = (LAS unsigned char*)lds;
    for (int u = tid; u < (LDS_BYTES - LDSCTL_OFF) / 4; u += NT) ((LAS unsigned*)(l3 + LDSCTL_OFF))[u] = 0u;
    __syncthreads();
    volatile LAS unsigned* MISC = (volatile LAS unsigned*)(l3 + MISC_OFF);
    XcdBarrier bar = xcd_barrier_post((unsigned*)(P.ws + WS_CTL) + CW_BAR, MISC + 8);

    ph_prologue(P, (float*)lds, gw, ngw, wave, lane);
    xcd_barrier(bar);
    const int gwh = (int)blockIdx.x * (NT / 64) + wave;
#pragma unroll 1
    for (int L = 0; L < DEPTH; ++L) {
#define LAUNDER() int lane_ = lane, tid_ = tid, gw_ = gw; asm volatile("" : "+v"(lane_), "+v"(tid_), "+v"(gw_))
        {
            pg8::Gemm g{(const bf16_t*)(P.ws + WS_XB), (const bf16_t*)(P.ws + WS_WIN) + (size_t)L * NIN * DM, M, NIN, DM}; pg8::StaticOrder S; S.init(M, NIN, G, (int)blockIdx.x);
            EpiG1 E{(bf16_t*)(P.ws + WS_ZB), (const float*)(P.ws + WS_RSTD), (const float*)(P.ws + WS_ROPE), P.b_merge + L * 2 * DM, P.out, L};
            pg8::gemm_phase<EpiG1, pg8::StaticOrder, true, true>(l3, g, S, E);
            { LAUNDER(); for (int it = ngw - 1 - gwh; it < NIN / 32; it += ngw) g1_wave_tile(P, L, true, 0, it, lane_); }
        }
        xcd_barrier(bar);
#if FAST_GMLP
        { LAUNDER(); ph_gmlp_fast(P, L, l3, vcu, G, tid_); }
#else
        { LAUNDER(); ph_gmlp_naive(P, L, vcu, G, tid_, NT); }
#endif
#if FAST_ATTN
        { LAUNDER(); ph_attn_fast(P, l3, gw_, ngw, wave, lane_); }
#else
        { LAUNDER(); ph_attn_naive(P, L, gw_, ngw, lane_); }
#endif
        { LAUNDER(); ph_attn_sample(P, L, gw_, ngw, lane_); ph_gmlp_sample(P, L, ngw - 1 - gw_, ngw, lane_); }
        xcd_barrier(bar);
        {
            pg8::Gemm g{(const bf16_t*)(P.ws + WS_ASG), (const bf16_t*)(P.ws + WS_W2) + (size_t)L * DM * DM, M, DM, DM}; pg8::StaticOrder S; S.init(M, DM, G, (int)blockIdx.x);
            EpiG2 E{(const bf16_t*)(P.ws + WS_ZB), (bf16_t*)(P.ws + WS_MG)};
            pg8::gemm_phase<EpiG2, pg8::StaticOrder, false, true>(l3, g, S, E);
            { LAUNDER(); if (wave == 0 && blockIdx.x < DM / 32) g2_wave_tile(P, L, true, 0, (int)blockIdx.x, lane_); }
        }
        xcd_barrier(bar);
        {
            pg8::Gemm g{(const bf16_t*)(P.ws + WS_MG), (const bf16_t*)(P.ws + WS_WOUT) + (size_t)L * DM * DM, M, DM, DM}; pg8::StaticOrder S; S.init(M, DM, G, (int)blockIdx.x);
            EpiG3 E{(float*)(P.ws + WS_Y)};
            pg8::gemm_phase<EpiG3, pg8::StaticOrder, false, true>(l3, g, S, E);
            { LAUNDER(); if (wave == 0 && blockIdx.x < DM / 32) g3_wave_tile(P, L, true, 0, (int)blockIdx.x, lane_); }
        }
        xcd_barrier(bar);
        { LAUNDER(); ph_post(P, L, gw_, ngw, lane_); }
        if (L + 1 < DEPTH) xcd_barrier(bar);
    }
}

extern "C" void kernel_launch(void* const* d_in, const int* in_sizes, int n_in, void* d_out, int out_size, void* d_ws, size_t ws_size, hipStream_t stream) {
    static int grid = 0;
    if (grid == 0) {
        if (n_in != 16 || (size_t)out_size != O_END || ws_size < WS_END) { fprintf(stderr, "kernel_launch: unexpected shapes n_in %d out %d ws %zu\n", n_in, out_size, ws_size); grid = -1; return; }
        int dev = 0, cus = 0, per_cu = 0;
        if (hipGetDevice(&dev) != hipSuccess || hipDeviceGetAttribute(&cus, hipDeviceAttributeMultiprocessorCount, dev) != hipSuccess) { grid = -1; return; }
        if (hipFuncSetAttribute((const void*)mega_kernel, hipFuncAttributeMaxDynamicSharedMemorySize, LDS_BYTES) != hipSuccess) { fprintf(stderr, "kernel_launch: hipFuncSetAttribute failed\n"); grid = -1; return; }
        if (hipOccupancyMaxActiveBlocksPerMultiprocessor(&per_cu, (const void*)mega_kernel, NT, LDS_BYTES) != hipSuccess || per_cu < 1) { fprintf(stderr, "kernel_launch: occupancy query says %d blocks per CU\n", per_cu); grid = -1; (void)hipGetLastError(); return; }
        grid = cus;
    }
    if (grid < 0) return;
    if (hipMemsetAsync((char*)d_ws + WS_CTL, 0, CTL_ZERO_BYTES, stream) != hipSuccess) return;
    Params P{};
    P.x_prompt = (const float*)d_in[0]; P.x_sample = (const float*)d_in[1]; P.cache[0] = (const float*)d_in[2]; P.cache[1] = (const float*)d_in[3]; P.cache[2] = (const float*)d_in[4];
    P.norm_pre = (const float*)d_in[5]; P.w_in = (const float*)d_in[6]; P.b_merge = (const float*)d_in[7]; P.v_norm_g = (const float*)d_in[8]; P.v_norm_b = (const float*)d_in[9];
    P.w_spatial = (const float*)d_in[10]; P.b_spatial = (const float*)d_in[11]; P.w_pa = (const float*)d_in[12]; P.w_pb = (const float*)d_in[13]; P.w_out = (const float*)d_in[14]; P.norm_post = (const float*)d_in[15];
    P.out = (float*)d_out; P.ws = (unsigned char*)d_ws;
    hipLaunchKernelGGL(mega_kernel, dim3(grid), dim3(NT), LDS_BYTES, stream, P);
}
```
